# Optimizing an MI355X kernel written in HIP

```python
import functools
import jax, jax.numpy as jnp
from jax import lax
import numpy as np

D_MODEL = 1024
BATCH = 4
SEQ = 4096
DEPTH = 1
DEC_BATCH = 128
DEC_SEQ = 1
PAST_LEN = 8192
PAGE_SIZE = 128

N_HEADS = 8
N_KV_HEADS = 2
HEAD_DIM = 64
GQA_GROUP = N_HEADS // N_KV_HEADS
ATTN_WIDTH = N_HEADS * HEAD_DIM
KV_WIDTH = N_KV_HEADS * HEAD_DIM
WINDOW = 128
BLOCK = WINDOW
ATTN_SCALE = HEAD_DIM ** -0.5
NEG_INF = -1e30
POOL_WINDOWS = (2, 4, 8, 16)
N_POOL_GROUPS = len(POOL_WINDOWS)
POOL_WIDTH = D_MODEL - ATTN_WIDTH
POOL_GROUP_DIM = POOL_WIDTH // N_POOL_GROUPS
POOL_HIST = max(POOL_WINDOWS) - 1
MIX_WIDTH = ATTN_WIDTH + POOL_WIDTH
IN_WIDTH = ATTN_WIDTH + 2 * KV_WIDTH + POOL_WIDTH
D_FF = -(-8 * D_MODEL // (3 * 256)) * 256
RMS_EPS = 1e-5

kernel_name = "hymba_swa_sink_alibi_pool_swiglu_step"


def rms_norm(x, g):
    x32 = x.astype(jnp.float32)
    y = x32 * lax.rsqrt(jnp.mean(x32 * x32, axis=-1, keepdims=True) + RMS_EPS)
    return (y * g.astype(jnp.float32)).astype(x.dtype)


def alibi_slopes():
    return jnp.exp2(-8.0 * jnp.arange(1, N_HEADS + 1, dtype=jnp.float32) / N_HEADS)


def attend(q, kk, vv, rel, valid, sinks):
    scores = jnp.einsum('...qhgd,...khd->...hgqk', q, kk,
                        preferred_element_type=jnp.float32) * ATTN_SCALE
    slopes = alibi_slopes().reshape(N_KV_HEADS, GQA_GROUP)[:, :, None, None]
    scores = scores - slopes * rel.astype(jnp.float32)[..., None, None, :, :]
    scores = jnp.where(valid[..., None, None, :, :], scores, NEG_INF)
    sink = sinks.astype(jnp.float32).reshape(N_KV_HEADS, GQA_GROUP)[:, :, None, None]
    sink = jnp.broadcast_to(sink, scores.shape[:-1] + (1,))
    probs = jax.nn.softmax(jnp.concatenate([scores, sink], axis=-1), axis=-1)[..., :-1]
    return jnp.einsum('...hgqk,...khd->...qhgd', probs.astype(vv.dtype), vv)


def banded_attention(q, k, v, sinks):
    B, S = q.shape[:2]
    nb = S // BLOCK
    qb = q.reshape(B, nb, BLOCK, N_KV_HEADS, GQA_GROUP, HEAD_DIM)
    kb = k.reshape(B, nb, BLOCK, N_KV_HEADS, HEAD_DIM)
    vb = v.reshape(B, nb, BLOCK, N_KV_HEADS, HEAD_DIM)

    def with_prev(xb):
        prev = jnp.pad(xb, ((0, 0), (1, 0), (0, 0), (0, 0), (0, 0)))[:, :-1]
        return jnp.concatenate([prev, xb], axis=2)

    qi = jnp.arange(BLOCK)[:, None]
    ki = jnp.arange(2 * BLOCK)[None, :]
    rel = BLOCK + qi - ki
    key_pos = (jnp.arange(nb)[:, None, None] - 1) * BLOCK + ki[None]
    valid = (rel >= 0) & (rel <= WINDOW) & (key_pos >= 0)
    out = attend(qb, with_prev(kb), with_prev(vb), rel, valid, sinks)
    return out.reshape(B, S, ATTN_WIDTH)


def buffered_attention(q, k_new, v_new, buf_k, buf_v, sinks, pos0):
    B, T = q.shape[:2]
    L = buf_k.shape[1]
    kk = jnp.concatenate([buf_k, k_new.astype(buf_k.dtype)], axis=1)
    vv = jnp.concatenate([buf_v, v_new.astype(buf_v.dtype)], axis=1)
    qi = jnp.arange(T)[:, None]
    ki = jnp.arange(L + T)[None, :]
    rel = L + qi - ki
    key_pos = pos0 - L + ki
    valid = (rel >= 0) & (rel <= WINDOW) & (key_pos >= 0)
    out = attend(q, kk, vv, rel, valid, sinks).reshape(B, T, ATTN_WIDTH)
    return out, kk[:, -L:], vv[:, -L:]


def pool_mix(hist, u, pos0, w_pool, pool_scale):
    B, T, C = u.shape
    Lh = hist.shape[1]
    z = jnp.concatenate([hist.astype(u.dtype), u], axis=1).astype(jnp.float32)
    row_pos = pos0 - Lh + jnp.arange(Lh + T)
    z = jnp.where((row_pos >= 0)[None, :, None], z, 0.0)
    cz = jnp.concatenate([jnp.zeros((B, 1, C), jnp.float32), jnp.cumsum(z, axis=1)], axis=1)
    pos = pos0 + jnp.arange(T)
    outs = []
    for g, w in enumerate(POOL_WINDOWS):
        sl = slice(g * POOL_GROUP_DIM, (g + 1) * POOL_GROUP_DIM)
        win_sum = cz[:, Lh + 1:Lh + 1 + T, sl] - cz[:, Lh + 1 - w:Lh + 1 - w + T, sl]
        count = jnp.minimum(w, pos + 1).astype(jnp.float32)[None, :, None]
        outs.append(win_sum / count - z[:, Lh:, sl])
    m = jnp.stack(outs, axis=2).astype(u.dtype)
    y = jnp.einsum('btgc,gcd->btgd', m, w_pool).reshape(B, T, POOL_WIDTH) * pool_scale
    new_hist = jnp.concatenate([hist.astype(u.dtype), u], axis=1)[:, -Lh:]
    return y, new_hist


def split_proj(proj):
    B, T = proj.shape[:2]
    q = proj[..., :ATTN_WIDTH].reshape(B, T, N_KV_HEADS, GQA_GROUP, HEAD_DIM)
    k = proj[..., ATTN_WIDTH:ATTN_WIDTH + KV_WIDTH].reshape(B, T, N_KV_HEADS, HEAD_DIM)
    v = proj[..., ATTN_WIDTH + KV_WIDTH:ATTN_WIDTH + 2 * KV_WIDTH].reshape(B, T, N_KV_HEADS, HEAD_DIM)
    u = proj[..., ATTN_WIDTH + 2 * KV_WIDTH:]
    return q, k, v, u


def prompt_mixer(q, k, v, u, sinks, w_pool, pool_scale):
    B, S = u.shape[:2]
    a = banded_attention(q, k, v, sinks)
    hist = jnp.zeros((B, POOL_HIST, POOL_WIDTH), u.dtype)
    p, new_pool = pool_mix(hist, u, 0, w_pool, pool_scale)
    n_keep = min(WINDOW, S)
    return jnp.concatenate([a, p], axis=-1), (k[:, -n_keep:], v[:, -n_keep:], new_pool)


def sample_mixer(q, k, v, u, buf_k, buf_v, hist, sinks, w_pool, pool_scale):
    a, new_k, new_v = buffered_attention(q, k, v, buf_k, buf_v, sinks, PAST_LEN)
    p, new_pool = pool_mix(hist, u, PAST_LEN, w_pool, pool_scale)
    return jnp.concatenate([a, p], axis=-1), (new_k, new_v, new_pool)


def decoder_layer(x, mix, norm1, w_in, w_out, norm2, w_gate, w_up, w_down):
    h = rms_norm(x, norm1)
    mixed, state = mix(*split_proj(h @ w_in))
    x = x + mixed @ w_out
    h = rms_norm(x, norm2)
    x = x + (jax.nn.silu(h @ w_gate) * (h @ w_up)) @ w_down
    return x, state


def setup_inputs(seed: int = 0) -> dict:
    key = jax.random.key(seed)
    ks = jax.random.split(key, 18)
    wbuf = min(WINDOW, PAST_LEN)
    f32 = jnp.float32
    nrm = lambda k, shape, s=1.0: jax.random.normal(k, shape, f32) * s
    return {
        "x_prompt": nrm(ks[0], (BATCH, SEQ, D_MODEL)),
        "x_sample": nrm(ks[1], (DEC_BATCH, DEC_SEQ, D_MODEL)),
        "cache_k_window": nrm(ks[2], (DEPTH, DEC_BATCH, wbuf, N_KV_HEADS, HEAD_DIM)),
        "cache_v_window": nrm(ks[3], (DEPTH, DEC_BATCH, wbuf, N_KV_HEADS, HEAD_DIM)),
        "state_pool": nrm(ks[4], (DEPTH, DEC_BATCH, POOL_HIST, POOL_WIDTH)),
        "norm1": 1.0 + nrm(ks[5], (DEPTH, D_MODEL), 0.05),
        "w_in": nrm(ks[6], (DEPTH, D_MODEL, IN_WIDTH), D_MODEL ** -0.5),
        "attn_sinks": nrm(ks[7], (DEPTH, N_HEADS), 0.5),
        "w_pool": nrm(ks[8], (DEPTH, N_POOL_GROUPS, POOL_GROUP_DIM, POOL_GROUP_DIM), POOL_GROUP_DIM ** -0.5),
        "pool_scale": 1.0 + nrm(ks[9], (DEPTH, POOL_WIDTH), 0.1),
        "w_out": nrm(ks[10], (DEPTH, MIX_WIDTH, D_MODEL), MIX_WIDTH ** -0.5),
        "norm2": 1.0 + nrm(ks[11], (DEPTH, D_MODEL), 0.05),
        "w_gate": nrm(ks[12], (DEPTH, D_MODEL, D_FF), D_MODEL ** -0.5),
        "w_up": nrm(ks[13], (DEPTH, D_MODEL, D_FF), D_MODEL ** -0.5),
        "w_down": nrm(ks[14], (DEPTH, D_FF, D_MODEL), D_FF ** -0.5),
        "final_norm": 1.0 + nrm(ks[15], (D_MODEL,), 0.05),
    }


def reference(x_prompt, x_sample, cache_k_window, cache_v_window, state_pool,
              norm1, w_in, attn_sinks, w_pool, pool_scale, w_out, norm2,
              w_gate, w_up, w_down, final_norm):
    xp, xs = x_prompt, x_sample
    kp_list, vp_list, pp_list, ks_list, vs_list, ps_list = [], [], [], [], [], []
    for l in range(DEPTH):
        ffn = dict(norm1=norm1[l], w_in=w_in[l], w_out=w_out[l], norm2=norm2[l],
                   w_gate=w_gate[l], w_up=w_up[l], w_down=w_down[l])
        pmix = functools.partial(prompt_mixer, sinks=attn_sinks[l], w_pool=w_pool[l],
                                 pool_scale=pool_scale[l])
        smix = functools.partial(sample_mixer, buf_k=cache_k_window[l], buf_v=cache_v_window[l],
                                 hist=state_pool[l], sinks=attn_sinks[l], w_pool=w_pool[l],
                                 pool_scale=pool_scale[l])
        xp, (kp, vp, pp) = decoder_layer(xp, pmix, **ffn)
        xs, (ks_, vs_, ps_) = decoder_layer(xs, smix, **ffn)
        kp_list.append(kp); vp_list.append(vp); pp_list.append(pp)
        ks_list.append(ks_); vs_list.append(vs_); ps_list.append(ps_)
    y_prompt = rms_norm(xp, final_norm)
    y_sample = rms_norm(xs, final_norm)
    new_k_prompt = jnp.stack(kp_list, axis=0)
    new_v_prompt = jnp.stack(vp_list, axis=0)
    new_pool_prompt = jnp.stack(pp_list, axis=0)
    new_k_sample = jnp.stack(ks_list, axis=0)
    new_v_sample = jnp.stack(vs_list, axis=0)
    new_pool_sample = jnp.stack(ps_list, axis=0)
    return (y_prompt, y_sample, new_k_prompt, new_v_prompt, new_pool_prompt,
            new_k_sample, new_v_sample, new_pool_sample)
```

```cpp
#include <hip/hip_runtime.h>
#include <cstdio>
#include <cstdint>
namespace pg8 {
#define PG8_LAS __attribute__((address_space(3)))
typedef unsigned short bf16_t;
typedef short bf16x8 __attribute__((ext_vector_type(8)));
typedef float f32x4 __attribute__((ext_vector_type(4)));
typedef unsigned u32x4 __attribute__((ext_vector_type(4)));
constexpr int BM = 256, BK = 64, HALF = 128, HTB = HALF * BK * 2  , STAGE_BYTES = 8 * HTB, NXCD = 8, WGM = 8;

__host__ __device__ __forceinline__ int lds_byte(int r, int c) { const int st = (r >> 4) * 2 + (c >> 5), rr = r & 15, cc = c & 31, ob = rr * 64 + cc * 2; return st * 1024 + (ob ^ (((ob >> 9) & 1) << 5)); }
__host__ __device__ __forceinline__ void stage_rc(int b, int& R, int& C) { const int st = b / 1024, sb = b % 1024, swz = sb ^ (((sb >> 9) & 1) << 5); R = (st >> 1) * 16 + swz / 64; C = (st & 1) * 32 + (swz % 64) / 2; }
__host__ __device__ __forceinline__ int perm32(int rho) { const int n = rho >> 4, i = rho & 15; return 8 * (i >> 2) + 4 * n + (i & 3); }

struct Unit { int pm, pn; };
struct Gemm { const bf16_t* A; const bf16_t* Bt; int M, N, K; };

struct StaticOrder {
    int nM, nN, nwg, G, c;
    __host__ __device__ void init(int M, int N, int G_, int c_) { nM = M / BM; nN = N / BM; nwg = nM * nN; G = G_; c = c_; }
    __host__ __device__ bool next(int i, Unit& u) const {
        const long L = (long)i * G + c; if (L >= nwg) return false;
        int wgid = (int)L; { const int q = nwg / NXCD, r = nwg % NXCD, xcd = wgid % NXCD, off = wgid / NXCD; wgid = (xcd < r ? xcd * (q + 1) : r * (q + 1) + (xcd - r) * q) + off; }
        const int nig = WGM * nN, gid = wgid / nig, fm = gid * WGM, gsz = (nM - fm) < WGM ? (nM - fm) : WGM;
        u.pm = fm + ((wgid % nig) % gsz); u.pn = (wgid % nig) / gsz; return true;
    }
    __device__ __forceinline__ void a_ready(const Unit&) const {}
    __device__ __forceinline__ void done(const Unit&) const {}
};

__device__ __forceinline__ unsigned cvt_pk_bf16(float lo, float hi) { unsigned r; asm volatile("v_cvt_pk_bf16_f32 %0, %1, %2" : "=v"(r) : "v"(lo), "v"(hi)); return r; }
typedef float f32x2 __attribute__((ext_vector_type(2)));

typedef unsigned u32x2 __attribute__((ext_vector_type(2)));
constexpr int ROWS_P = 16384, ROWS_V = 16512;
constexpr size_t OFF_Y = 0, OFF_KP = 16908288, OFF_VP = 16973824, OFF_PP = 17039360, OFF_KS = 17070080, OFF_VS = 19167232, OFF_PS = 21264384, OUT_TOTAL = 22247424;
constexpr float RMS_EPS = 1e-5f;

__device__ __forceinline__ float* side_dst(float* out, int row, int col) {
    if (row < ROWS_P) { const int b = row >> 12, t = row & 4095;
        if (col < 768) { if (t < 3968) return nullptr; const bool isv = col >= 640; return out + (isv ? OFF_VP : OFF_KP) + (size_t)((b * 128 + (t - 3968)) * 128 + (col - (isv ? 640 : 512))); }
        if (t < 4081) return nullptr; return out + OFF_PP + (size_t)((b * 15 + (t - 4081)) * 512 + (col - 768)); }
    if (row < ROWS_V) { const int b = row - ROWS_P;
        if (col < 768) { const bool isv = col >= 640; return out + (isv ? OFF_VS : OFF_KS) + (size_t)((b * 128 + 127) * 128 + (col - (isv ? 640 : 512))); }
        return out + OFF_PS + (size_t)((b * 15 + 14) * 512 + (col - 768)); }
    return nullptr;
}
struct EpiProj {
    static constexpr bool PERM = true, AFTER_DRAIN = false;
    bf16_t* P; const float* rstd; float* out;
    __device__ __forceinline__ void operator()(const f32x4 (&acc)[2][2][4][2], const Unit& u, int wr, int wc, int fr, int fq) const {
        const int col0 = u.pn * BM + wc * 32 + 8 * fq;
        const bool side = (u.pn >= 2) && (u.pm == 64 || (u.pm & 15) == 15);
#pragma unroll
        for (int ai = 0; ai < 2; ++ai)
#pragma unroll
            for (int m = 0; m < 4; ++m) {
                const int row = u.pm * BM + ai * HALF + wr * 64 + m * 16 + fr;
                const float rs = rstd[row];
                bf16_t* rowp = P + (size_t)row * 1280 + col0;
#pragma unroll
                for (int bj = 0; bj < 2; ++bj) {
                    const f32x4 v0 = acc[ai][bj][m][0] * rs, v1 = acc[ai][bj][m][1] * rs;
                    u32x4 w; w.x = cvt_pk_bf16(v0[0], v0[1]); w.y = cvt_pk_bf16(v0[2], v0[3]); w.z = cvt_pk_bf16(v1[0], v1[1]); w.w = cvt_pk_bf16(v1[2], v1[3]);
                    *(u32x4*)(rowp + bj * HALF) = w;
                    if (side) { float* d = side_dst(out, row, col0 + bj * HALF); if (d) { *(f32x4*)d = v0; *(f32x4*)(d + 4) = v1; } }
                }
            }
    }
};
template <bool FIRST> struct EpiRes {
    static constexpr bool PERM = false, AFTER_DRAIN = false;
    const float* xp; const float* xs; float* out; bf16_t* XN; float* SS;
    __device__ __forceinline__ void operator()(const f32x4 (&acc)[2][2][4][2], const Unit& u, int wr, int wc, int fr, int fq) const {
        const int col0 = u.pn * BM + wc * 32 + 4 * fq;
#pragma unroll
        for (int ai = 0; ai < 2; ++ai)
#pragma unroll
            for (int m = 0; m < 4; ++m) {
                const int row = u.pm * BM + ai * HALF + wr * 64 + m * 16 + fr;
                if (row < ROWS_V) {
                    float* orow = out + (size_t)row * 1024 + col0;
                    const float* xr = FIRST ? ((row < ROWS_P) ? xp + (size_t)row * 1024 : xs + (size_t)(row - ROWS_P) * 1024) + col0 : orow;
                    float ss = 0.f;
#pragma unroll
                    for (int bj = 0; bj < 2; ++bj)
#pragma unroll
                        for (int n = 0; n < 2; ++n) {
                            const int c = bj * HALF + n * 16;
                            const f32x4 v = *(const f32x4*)(xr + c) + acc[ai][bj][m][n];
                            *(f32x4*)(orow + c) = v;
                            if (FIRST) { u32x2 w; w.x = cvt_pk_bf16(v[0], v[1]); w.y = cvt_pk_bf16(v[2], v[3]); *(u32x2*)(XN + (size_t)row * 1024 + col0 + c) = w; }
                            ss += (v[0] * v[0] + v[1] * v[1]) + (v[2] * v[2] + v[3] * v[3]);
                        }
                    ss += __shfl_xor(ss, 16); ss += __shfl_xor(ss, 32);
                    if (fq == 0) SS[(size_t)row * 16 + u.pn * 4 + wc] = ss;
                }
            }
    }
};
struct EpiSwiGLU {
    static constexpr bool PERM = true, AFTER_DRAIN = false;
    bf16_t* H; const float* SS;
    __device__ __forceinline__ void operator()(const f32x4 (&acc)[2][2][4][2], const Unit& u, int wr, int wc, int fr, int fq) const {
        const int colh = u.pn * HALF + wc * 32 + 8 * fq;
#pragma unroll
        for (int ai = 0; ai < 2; ++ai)
#pragma unroll
            for (int m = 0; m < 4; ++m) {
                const int row = u.pm * BM + ai * HALF + wr * 64 + m * 16 + fr;
                const f32x4* sp = (const f32x4*)(SS + (size_t)row * 16);
                const f32x4 a = (sp[0] + sp[1]) + (sp[2] + sp[3]);
                const float rs = 1.0f / sqrtf(((a[0] + a[1]) + (a[2] + a[3])) * (1.0f / 1024.0f) + RMS_EPS);
                float hv[8];
#pragma unroll
                for (int n = 0; n < 2; ++n)
#pragma unroll
                    for (int j = 0; j < 4; ++j) {
                        const float g = acc[ai][0][m][n][j] * rs, uu = acc[ai][1][m][n][j] * rs;
                        const float sg = g * __builtin_amdgcn_rcpf(1.0f + __builtin_amdgcn_exp2f(-1.4426950408889634f * g));
                        hv[n * 4 + j] = sg * uu;
                    }
                u32x4 w; w.x = cvt_pk_bf16(hv[0], hv[1]); w.y = cvt_pk_bf16(hv[2], hv[3]); w.z = cvt_pk_bf16(hv[4], hv[5]); w.w = cvt_pk_bf16(hv[6], hv[7]);
                *(u32x4*)(H + (size_t)row * 2816 + colh) = w;
            }
    }
};

template <class Epi, class Sched, bool ALIGN_EPI = false, bool SP2 = false>
__device__ __forceinline__ void gemm_phase(PG8_LAS unsigned char* lds, const Gemm g, const Sched& S, const Epi& E) {
    const int tid = threadIdx.x, wid = __builtin_amdgcn_readfirstlane(tid >> 6), lane = tid & 63, wr = wid >> 2, wc = wid & 3, fr = lane & 15, fq = lane >> 4;
    const int K = g.K, nt = K / BK;
    unsigned voffA[2], voffB[2];
#pragma unroll
    for (int i = 0; i < 2; ++i) { int R, C; stage_rc(tid * 16 + i * 8192, R, C); const int Rb = Epi::PERM ? ((R & ~31) + perm32(R & 31)) : R;
        voffA[i] = (unsigned)(R * K + C) * 2u; voffB[i] = (unsigned)(Rb * K + C) * 2u; }
    const size_t kstep = (size_t)(BK * 2);
    const size_t hstep = (size_t)HALF * K * 2;
    const size_t tstep = 2 * hstep;
    const unsigned ldsw = (unsigned)wid * 1024u;
    const int aoff = lds_byte(wr * 64 + fr, fq * 8), boff = lds_byte(wc * 32 + fr, fq * 8);
#define PG8_SA(b, h) (((b) * 2 + (h)) * HTB)
#define PG8_SB(b, h) ((4 + (b) * 2 + (h)) * HTB)
#define PG8_STAGE(bufoff, gbase, voff) do { _Pragma("unroll") for (int _i = 0; _i < 2; ++_i) \
        __builtin_amdgcn_global_load_lds((const unsigned*)((const char*)(gbase) + (voff)[_i]), (PG8_LAS unsigned*)(lds + (bufoff) + ldsw + _i * 8192), 16, 0, 0); } while (0)
#define PG8_LDA(dst, b, h) do { _Pragma("unroll") for (int m = 0; m < 4; ++m) _Pragma("unroll") for (int k = 0; k < 2; ++k) dst[m][k] = *(const PG8_LAS bf16x8*)(lds + PG8_SA(b, h) + aoff + m * 2048 + k * 1024); } while (0)
#define PG8_LDB(dst, b, h) do { _Pragma("unroll") for (int n = 0; n < 2; ++n) _Pragma("unroll") for (int k = 0; k < 2; ++k) dst[n][k] = *(const PG8_LAS bf16x8*)(lds + PG8_SB(b, h) + boff + n * 2048 + k * 1024); } while (0)
#define PG8_MMA(ai, bj, At, Bt) do { __builtin_amdgcn_s_setprio(1); _Pragma("unroll") for (int m = 0; m < 4; ++m) _Pragma("unroll") for (int n = 0; n < 2; ++n) _Pragma("unroll") for (int k = 0; k < 2; ++k) \
        acc[ai][bj][m][n] = __builtin_amdgcn_mfma_f32_16x16x32_bf16(Bt[n][k], At[m][k], acc[ai][bj][m][n], 0, 0, 0); __builtin_amdgcn_s_setprio(0); } while (0)
#define PG8_WAIT_V(n) asm volatile("s_waitcnt vmcnt(" #n ")" ::: "memory")
#define PG8_WAIT_L(n) asm volatile("s_waitcnt lgkmcnt(" #n ")" ::: "memory")
#define PG8_BAR __builtin_amdgcn_s_barrier()
#define PG8_SCHED __builtin_amdgcn_sched_barrier(0)
    Unit cur, nxt; int ui = 0;
    if (!S.next(0, cur)) return;
    f32x4 acc[2][2][4][2];
#pragma unroll
    for (int a = 0; a < 2; ++a)
#pragma unroll
        for (int b = 0; b < 2; ++b)
#pragma unroll
            for (int m = 0; m < 4; ++m)
#pragma unroll
                for (int n = 0; n < 2; ++n) acc[a][b][m][n] = (f32x4){0.f, 0.f, 0.f, 0.f};
    bf16x8 At[4][2], B0[2][2], B1[2][2];
    const char* cA = (const char*)g.A + (size_t)cur.pm * tstep; const char* cB = (const char*)g.Bt + (size_t)cur.pn * tstep;
    S.a_ready(cur);
    if constexpr (SP2) {
        PG8_STAGE(PG8_SB(0, 0), cB, voffB); PG8_STAGE(PG8_SB(0, 1), cB + hstep, voffB); PG8_STAGE(PG8_SA(0, 0), cA, voffA); PG8_STAGE(PG8_SA(0, 1), cA + hstep, voffA);
        if (wr == 1) PG8_BAR;
        PG8_WAIT_V(2); PG8_BAR;
        PG8_STAGE(PG8_SB(1, 0), cB + kstep, voffB); PG8_STAGE(PG8_SA(1, 0), cA + kstep, voffA); PG8_STAGE(PG8_SB(1, 1), cB + hstep + kstep, voffB);
        PG8_WAIT_V(6); PG8_BAR;
    } else {
        PG8_STAGE(PG8_SB(0, 0), cB, voffB); PG8_STAGE(PG8_SA(0, 0), cA, voffA); PG8_STAGE(PG8_SB(0, 1), cB + hstep, voffB); PG8_STAGE(PG8_SA(0, 1), cA + hstep, voffA);
        if (wr == 1) PG8_BAR;
        PG8_WAIT_V(4); PG8_BAR;
        PG8_STAGE(PG8_SB(1, 0), cB + kstep, voffB); PG8_STAGE(PG8_SA(1, 0), cA + kstep, voffA); PG8_STAGE(PG8_SB(1, 1), cB + hstep + kstep, voffB);
        PG8_WAIT_V(6); PG8_BAR;
    }
    for (;;) {
        const bool has_next = S.next(ui + 1, nxt);
        const char* nA = has_next ? (const char*)g.A + (size_t)nxt.pm * tstep : cA; const char* nB = has_next ? (const char*)g.Bt + (size_t)nxt.pn * tstep : cB;
        for (int t = 0; t < nt; t += 2) {
            const bool last = (t == nt - 2);
            const char* a1 = cA + (size_t)(t + 1) * kstep;
            const char* a2 = last ? nA : cA + (size_t)(t + 2) * kstep; const char* b2 = last ? nB : cB + (size_t)(t + 2) * kstep;
            const char* a3 = a2 + kstep; const char* b3 = b2 + kstep;
            if (last && has_next) S.a_ready(nxt);
            if constexpr (SP2) {
            PG8_LDB(B0, 0, 0); PG8_LDB(B1, 0, 1); PG8_SCHED; PG8_LDA(At, 0, 0); PG8_STAGE(PG8_SA(1, 1), a1 + hstep, voffA);
            PG8_WAIT_V(8); PG8_WAIT_L(0); PG8_BAR; PG8_MMA(0, 0, At, B0); PG8_MMA(0, 1, At, B1); PG8_BAR; PG8_SCHED;
            PG8_LDA(At, 0, 1); PG8_STAGE(PG8_SB(0, 0), b2, voffB); PG8_STAGE(PG8_SB(0, 1), b2 + hstep, voffB); PG8_STAGE(PG8_SA(0, 0), a2, voffA);
            PG8_WAIT_V(8); PG8_WAIT_L(0); PG8_BAR; PG8_MMA(1, 0, At, B0); PG8_MMA(1, 1, At, B1); PG8_BAR; PG8_SCHED;
            PG8_LDB(B0, 1, 0); PG8_LDB(B1, 1, 1); PG8_SCHED; PG8_LDA(At, 1, 0); PG8_STAGE(PG8_SA(0, 1), a2 + hstep, voffA);
            PG8_WAIT_V(8); PG8_WAIT_L(0); PG8_BAR; PG8_MMA(0, 0, At, B0); PG8_MMA(0, 1, At, B1); PG8_BAR; PG8_SCHED;
            PG8_LDA(At, 1, 1); PG8_STAGE(PG8_SB(1, 0), b3, voffB); PG8_STAGE(PG8_SB(1, 1), b3 + hstep, voffB); PG8_STAGE(PG8_SA(1, 0), a3, voffA);
            PG8_WAIT_V(8); PG8_WAIT_L(0); PG8_BAR; PG8_MMA(1, 0, At, B0); PG8_MMA(1, 1, At, B1); PG8_BAR; PG8_SCHED;
            } else {
            PG8_LDB(B0, 0, 0); PG8_SCHED; PG8_LDA(At, 0, 0); PG8_STAGE(PG8_SA(1, 1), a1 + hstep, voffA);
            PG8_WAIT_L(8); PG8_BAR; PG8_WAIT_L(0); PG8_MMA(0, 0, At, B0); PG8_BAR; PG8_SCHED;
            PG8_LDB(B1, 0, 1); PG8_STAGE(PG8_SB(0, 0), b2, voffB);
            PG8_BAR; PG8_WAIT_L(0); PG8_MMA(0, 1, At, B1); PG8_BAR;
            PG8_LDA(At, 0, 1); PG8_STAGE(PG8_SA(0, 0), a2, voffA);
            PG8_BAR; PG8_WAIT_L(0); PG8_MMA(1, 0, At, B0); PG8_BAR; PG8_SCHED;
            PG8_STAGE(PG8_SB(0, 1), b2 + hstep, voffB);
            PG8_WAIT_V(6); PG8_BAR; PG8_MMA(1, 1, At, B1); PG8_BAR;
            PG8_LDB(B0, 1, 0); PG8_SCHED; PG8_LDA(At, 1, 0); PG8_STAGE(PG8_SA(0, 1), a2 + hstep, voffA);
            PG8_WAIT_L(8); PG8_BAR; PG8_WAIT_L(0); PG8_MMA(0, 0, At, B0); PG8_BAR; PG8_SCHED;
            PG8_LDB(B1, 1, 1); PG8_STAGE(PG8_SB(1, 0), b3, voffB);
            PG8_BAR; PG8_WAIT_L(0); PG8_MMA(0, 1, At, B1); PG8_BAR;
            PG8_LDA(At, 1, 1); PG8_STAGE(PG8_SA(1, 0), a3, voffA);
            PG8_BAR; PG8_WAIT_L(0); PG8_MMA(1, 0, At, B0); PG8_BAR; PG8_SCHED;
            PG8_STAGE(PG8_SB(1, 1), b3 + hstep, voffB);
            PG8_WAIT_V(6); PG8_BAR; PG8_MMA(1, 1, At, B1); PG8_BAR;
            }
        }
        if constexpr (ALIGN_EPI) { if (wr == 0) PG8_BAR; }
        if constexpr (!Epi::AFTER_DRAIN) { E(acc, cur, wr, wc, fr, fq); S.done(cur); }
        if (!has_next) break;
#pragma unroll
        for (int a = 0; a < 2; ++a)
#pragma unroll
            for (int b = 0; b < 2; ++b)
#pragma unroll
                for (int m = 0; m < 4; ++m)
#pragma unroll
                    for (int n = 0; n < 2; ++n) acc[a][b][m][n] = (f32x4){0.f, 0.f, 0.f, 0.f};
        cur = nxt; cA = nA; cB = nB; ++ui;
        if constexpr (ALIGN_EPI) { if (wr == 1) PG8_BAR; }
    }
    PG8_WAIT_V(0);
    if constexpr (!ALIGN_EPI) { if (wr == 0) PG8_BAR; }
    PG8_BAR;
    if constexpr (Epi::AFTER_DRAIN) { E.fused(acc, cur, wr, wc, fr, fq, lds, wid, lane); S.done(cur); }
#undef PG8_SA
#undef PG8_SB
#undef PG8_STAGE
#undef PG8_LDA
#undef PG8_LDB
#undef PG8_MMA
#undef PG8_WAIT_V
#undef PG8_WAIT_L
#undef PG8_BAR
#undef PG8_SCHED
}
}
#define GAS __attribute__((address_space(1)))
#define LAS __attribute__((address_space(3)))
typedef unsigned short bf16;
typedef unsigned v4u __attribute__((ext_vector_type(4)));
typedef float f32x4 __attribute__((ext_vector_type(4)));
typedef short bf16x8 __attribute__((ext_vector_type(8)));
typedef GAS unsigned gu32;
typedef GAS unsigned long long gu64;
#define RLX_AGENT __ATOMIC_RELAXED, __HIP_MEMORY_SCOPE_AGENT
#define LDS_WAIT() asm volatile("s_waitcnt lgkmcnt(0)" ::: "memory")
#define VM_WAIT() asm volatile("s_waitcnt vmcnt(0)" ::: "memory")
__device__ __forceinline__ unsigned long long rt() { return __builtin_amdgcn_s_memrealtime(); }
__device__ __forceinline__ unsigned f2bf(float f) { unsigned u = __builtin_bit_cast(unsigned, f); return (u + 0x7fffu + ((u >> 16) & 1u)) >> 16; }
__device__ __forceinline__ unsigned pk2(float lo, float hi) { return f2bf(lo) | (f2bf(hi) << 16); }

#define XB_TMO      128
#define XB_XCNT(j)  (256  + 64 * (j))
#define XB_XSUB(j)  (1280 + 64 * (j))
#define XB_XGEN(j)  (2304 + 64 * (j))
#define XB_TOP      3328
#define XB_TOPGEN   3392
#define XCD_BAR_WORDS 3456
#define XB_SPIN_CAP (1u << 18)

__device__ __forceinline__ unsigned xb_ld(unsigned* p)              { return __hip_atomic_load(p, __ATOMIC_RELAXED, __HIP_MEMORY_SCOPE_AGENT); }
__device__ __forceinline__ unsigned xb_add(unsigned* p, unsigned v) { return __hip_atomic_fetch_add(p, v, __ATOMIC_RELAXED, __HIP_MEMORY_SCOPE_AGENT); }
__device__ __forceinline__ unsigned xb_xcc_id() { return (unsigned)__builtin_amdgcn_s_getreg((3 << 11) | 20) & 0xFu; }
#define XB_SPIN(cond, bar) do { unsigned _sp = 0; while (cond) { __builtin_amdgcn_s_sleep(1); \
    if ((++_sp & 255u) == 0u) { if (xb_ld(&(bar)[XB_TMO])) break; if (_sp > XB_SPIN_CAP) { atomicAdd(&(bar)[XB_TMO], 1u); break; } } } } while (0)

struct XcdBarrier {
    unsigned* bar; unsigned x;
    volatile LAS unsigned* st;
};

__device__ __forceinline__ XcdBarrier xcd_barrier_post(unsigned* bar, volatile LAS unsigned* st) {
    XcdBarrier b; b.bar = bar; b.x = xb_xcc_id(); b.st = st;
    if (threadIdx.x == 0) (void)xb_add(&bar[XB_XCNT(b.x)], 1u);
    return b;
}
__device__ __forceinline__ void xcd_barrier_complete(unsigned* bar, unsigned x, unsigned& nloc, unsigned& nx) {
    const unsigned G = gridDim.x * gridDim.y * gridDim.z;
    unsigned sum, cnt, mine, sp = 0u;
    for (;;) {
        sum = 0u; cnt = 0u; mine = 0u;
#pragma unroll
        for (unsigned j = 0; j < 16; ++j) { const unsigned c = xb_ld(&bar[XB_XCNT(j)]); sum += c; cnt += (c > 0u) ? 1u : 0u; mine = (j == x) ? c : mine; }
        if (sum == G) break;
        __builtin_amdgcn_s_sleep(1);
        if ((++sp & 255u) == 0u) { if (xb_ld(&bar[XB_TMO])) break; if (sp > XB_SPIN_CAP) { atomicAdd(&bar[XB_TMO], 1u); break; } }
    }
    nloc = mine > 0u ? mine : 1u; nx = cnt > 0u ? cnt : 1u;
}

__device__ __forceinline__ void xcd_barrier(const XcdBarrier& b) {
    asm volatile("s_waitcnt vmcnt(0)" ::: "memory");
    __syncthreads();
    if (threadIdx.x == 0) {
        unsigned* bar = b.bar;
        __builtin_amdgcn_s_waitcnt(0);
        unsigned nloc = b.st[0], nx = b.st[1];
        if (nloc == 0u) { xcd_barrier_complete(bar, b.x, nloc, nx); b.st[0] = nloc; b.st[1] = nx; }
        const unsigned old = xb_add(&bar[XB_XSUB(b.x)], 1u);
        const unsigned gen = old / nloc;
        if (old + 1u == (gen + 1u) * nloc) {
            __builtin_amdgcn_fence(__ATOMIC_RELEASE, "agent");
            asm volatile("s_waitcnt vmcnt(0)" ::: "memory");
            const unsigned og = xb_add(&bar[XB_TOP], 1u);
            const unsigned tg = og / nx;
            if (og + 1u == (tg + 1u) * nx) xb_add(&bar[XB_TOPGEN], 1u);
            else XB_SPIN(xb_ld(&bar[XB_TOPGEN]) == tg, bar);
            __builtin_amdgcn_fence(__ATOMIC_ACQUIRE, "agent");
            xb_add(&bar[XB_XGEN(b.x)], 1u);
            asm volatile("s_waitcnt vmcnt(0)" ::: "memory");
        } else {
            XB_SPIN(xb_ld(&bar[XB_XGEN(b.x)]) == gen, bar);
            __builtin_amdgcn_fence(__ATOMIC_ACQUIRE, "agent");
            asm volatile("s_waitcnt vmcnt(0)" ::: "memory");
        }
    }
    __syncthreads();
}

constexpr int NWAVES = 8;
constexpr int DM = 1024, MP = 16384, MSMP = 128, MV = 16512, MPAD = 16640, NIN = 1280, DFF = 2816;
constexpr size_t MiB = 1u << 20;
constexpr size_t WS_CTL = 0, CTL_ZERO_BYTES = 65536;
constexpr size_t WS_RSTD = 1 * MiB;
constexpr size_t WS_SS2 = 2 * MiB, WS_SS3 = 4 * MiB;
constexpr size_t WS_WIN = 6 * MiB, WS_WOUT = 9 * MiB, WS_WGU = 11 * MiB, WS_WD = 22 * MiB;
constexpr size_t WS_XN = 28 * MiB;
constexpr size_t WS_PROJ = 61 * MiB;
constexpr size_t WS_MIX = 102 * MiB;
constexpr size_t WS_H = 135 * MiB;
constexpr size_t WS_END = 225 * MiB;
static_assert(WS_WIN + (size_t)NIN * DM * 2 <= WS_WOUT && WS_WGU + (size_t)2 * DFF * DM * 2 <= WS_WD && WS_WD + (size_t)DM * DFF * 2 <= WS_XN, "ws map: weights");
static_assert(WS_XN + (size_t)MPAD * DM * 2 <= WS_PROJ && WS_PROJ + (size_t)MPAD * NIN * 2 <= WS_MIX && WS_MIX + (size_t)MPAD * DM * 2 <= WS_H && WS_H + (size_t)MPAD * DFF * 2 <= WS_END, "ws map: activations");
static_assert(WS_SS2 + (size_t)MPAD * 64 <= WS_SS3 && WS_SS3 + (size_t)MPAD * 64 <= WS_WIN, "ws map: stats");
constexpr int CW_BAR = 4096;
static_assert((CW_BAR + XCD_BAR_WORDS) * 4 <= (int)CTL_ZERO_BYTES, "barrier words inside the memset region");
constexpr int RING_OFF = 0, RING_BYTES = 131072, LDSCTL_OFF = RING_BYTES, MISC_OFF = LDSCTL_OFF + 320, LDS_BYTES = 147456;

__device__ __forceinline__ float wave_sum(float v) {
#pragma unroll
    for (int o = 1; o < 64; o <<= 1) v += __shfl_xor(v, o);
    return v;
}
__device__ __forceinline__ float bflo(unsigned w) { return __builtin_bit_cast(float, w << 16); }
__device__ __forceinline__ float bfhi(unsigned w) { return __builtin_bit_cast(float, w & 0xffff0000u); }
__device__ __forceinline__ float bf1(bf16 b) { return __builtin_bit_cast(float, (unsigned)b << 16); }

template <int MODE>
__device__ __forceinline__ void p0_transpose_item(const float* W, int K, int N, const float* gain, bf16* WT, LAS float* scr, int item, int lane) {
    const int nblk = N / 32, kb = item / nblk, nb = item % nblk, k0 = 64 * kb, n0 = 32 * nb;
#pragma unroll 8
    for (int i = 0; i < 32; ++i) { const int kk = 2 * i + (lane >> 5); float w = W[(size_t)(k0 + kk) * N + n0 + (lane & 31)]; if (gain) w *= gain[k0 + kk]; scr[kk * 33 + (lane & 31)] = w; }
    LDS_WAIT(); asm volatile("" ::: "memory");
    const int c = lane & 7;
#pragma unroll
    for (int j = 0; j < 4; ++j) { const int n = (lane >> 3) + 8 * j; const LAS float* s = scr + (8 * c) * 33 + n;
        v4u o; o.x = pk2(s[0 * 33], s[1 * 33]); o.y = pk2(s[2 * 33], s[3 * 33]); o.z = pk2(s[4 * 33], s[5 * 33]); o.w = pk2(s[6 * 33], s[7 * 33]);
        const int nn = n0 + n, orow = (MODE == 0) ? nn : ((nn >> 7) * 256 + (MODE == 2 ? 128 : 0) + (nn & 127));
        *(GAS v4u*)(WT + (size_t)orow * K + k0 + 8 * c) = o; }
    LDS_WAIT(); asm volatile("" ::: "memory");
}

struct Args { const float* in[16]; float* out; unsigned char* ws; };

__global__ void __launch_bounds__(NWAVES * 64, 2) hymba_fwd(Args args) {
    extern __shared__ __attribute__((aligned(16))) unsigned char lds[];
    LAS unsigned char* const L = (LAS unsigned char*)lds;
    volatile LAS unsigned* const MISC = (volatile LAS unsigned*)(L + MISC_OFF);
    const int tid = threadIdx.x, lane = tid & 63, wave = __builtin_amdgcn_readfirstlane(tid >> 6);
    const int G = gridDim.x; const int bx = blockIdx.x; const int vcu = (G % 8 == 0) ? (bx % 8) * (G / 8) + bx / 8 : bx;
    const int gw = vcu * NWAVES + wave, NGW = G * NWAVES;
    unsigned char* const ws = args.ws;
    const float* const x_p = args.in[0]; const float* const x_s = args.in[1]; const float* const cache_k = args.in[2]; const float* const cache_v = args.in[3];
    const float* const state_pool = args.in[4]; const float* const norm1 = args.in[5]; const float* const w_in = args.in[6]; const float* const sinks = args.in[7];
    const float* const w_pool = args.in[8]; const float* const pool_scale = args.in[9]; const float* const w_out = args.in[10]; const float* const norm2 = args.in[11];
    const float* const w_gate = args.in[12]; const float* const w_up = args.in[13]; const float* const w_down = args.in[14]; const float* const final_norm = args.in[15];
    float* const out = args.out;
    gu32* const ctl = (gu32*)(ws + WS_CTL);
    float* const RSTD = (float*)(ws + WS_RSTD); float* const SS2 = (float*)(ws + WS_SS2); float* const SS3 = (float*)(ws + WS_SS3);
    bf16* const Win_t = (bf16*)(ws + WS_WIN); bf16* const Wout_t = (bf16*)(ws + WS_WOUT); bf16* const Wgu_t = (bf16*)(ws + WS_WGU); bf16* const Wd_t = (bf16*)(ws + WS_WD);
    bf16* const XN = (bf16*)(ws + WS_XN); bf16* const PROJ = (bf16*)(ws + WS_PROJ); bf16* const MIX = (bf16*)(ws + WS_MIX); bf16* const HB = (bf16*)(ws + WS_H);

    for (int u = tid; u < (LDS_BYTES - LDSCTL_OFF) / 4; u += NWAVES * 64) ((LAS unsigned*)(L + LDSCTL_OFF))[u] = 0u;
    __syncthreads();
    XcdBarrier bar = xcd_barrier_post((unsigned*)(ctl + CW_BAR), MISC + 8);

    {
        LAS float* scr = (LAS float*)(L + RING_OFF + wave * 16384);
        constexpr int I_IN = (DM / 64) * (NIN / 32), I_OUT = (DM / 64) * (DM / 32), I_G = (DM / 64) * (DFF / 32), I_D = (DFF / 64) * (DM / 32);
        constexpr int NITEMS = I_IN + I_OUT + 2 * I_G + I_D;
        for (int it = gw; it < NITEMS; it += NGW) {
            int r = it;
            if (r < I_IN) { p0_transpose_item<0>(w_in, DM, NIN, norm1, Win_t, scr, r, lane); continue; } r -= I_IN;
            if (r < I_OUT) { p0_transpose_item<0>(w_out, DM, DM, nullptr, Wout_t, scr, r, lane); continue; } r -= I_OUT;
            if (r < I_G) { p0_transpose_item<1>(w_gate, DM, DFF, norm2, Wgu_t, scr, r, lane); continue; } r -= I_G;
            if (r < I_G) { p0_transpose_item<2>(w_up, DM, DFF, norm2, Wgu_t, scr, r, lane); continue; } r -= I_G;
            p0_transpose_item<0>(w_down, DFF, DM, nullptr, Wd_t, scr, r, lane);
        }
        for (int m = gw; m < MPAD; m += NGW) {
            GAS unsigned long long* o8 = (GAS unsigned long long*)(XN + (size_t)m * DM) + lane;
            if (m < MV) {
                const float* xrow = (m < MP) ? x_p + (size_t)m * DM : x_s + (size_t)(m - MP) * DM;
                const GAS f32x4* xr = (const GAS f32x4*)xrow + lane;
                f32x4 v[4]; float s = 0.f;
#pragma unroll
                for (int j = 0; j < 4; ++j) { v[j] = xr[64 * j]; s += (v[j].x * v[j].x + v[j].y * v[j].y) + (v[j].z * v[j].z + v[j].w * v[j].w); }
                const float rstd = 1.f / sqrtf(wave_sum(s) * (1.f / DM) + pg8::RMS_EPS);
                if (lane == 0) RSTD[m] = rstd;
#pragma unroll
                for (int j = 0; j < 4; ++j) o8[64 * j] = (unsigned long long)pk2(v[j].x, v[j].y) | ((unsigned long long)pk2(v[j].z, v[j].w) << 32);
            } else {
                if (lane == 0) RSTD[m] = 0.f;
#pragma unroll
                for (int j = 0; j < 4; ++j) o8[64 * j] = 0ull;
            }
        }
        {
            const int gt = gw * 64 + lane, NT = NGW * 64;
            const f32x4* ck4 = (const f32x4*)cache_k; const f32x4* cv4 = (const f32x4*)cache_v; const f32x4* sp4 = (const f32x4*)state_pool;
            f32x4* ok4 = (f32x4*)(out + pg8::OFF_KS); f32x4* ov4 = (f32x4*)(out + pg8::OFF_VS); f32x4* op4 = (f32x4*)(out + pg8::OFF_PS);
            for (int i = gt; i < 128 * 127 * 32; i += NT) { const int b = i / (127 * 32), r = i % (127 * 32); ok4[b * 4096 + r] = ck4[b * 4096 + 32 + r]; ov4[b * 4096 + r] = cv4[b * 4096 + 32 + r]; }
            for (int i = gt; i < 128 * 14 * 128; i += NT) { const int b = i / (14 * 128), r = i % (14 * 128); op4[b * 1920 + r] = sp4[b * 1920 + 128 + r]; }
        }
    }
    xcd_barrier(bar);

    {
        pg8::Gemm g{XN, Win_t, MPAD, NIN, DM}; pg8::StaticOrder S; S.init(MPAD, NIN, G, bx);
        pg8::EpiProj E{PROJ, RSTD, out};
        pg8::gemm_phase<pg8::EpiProj, pg8::StaticOrder, true, true>(L + RING_OFF, g, S, E);
    }
    xcd_barrier(bar);

    {
        const int gt = gw * 64 + lane, NT = NGW * 64;
        for (int item = gt; item < MV * 8; item += NT) {
            const int row = item >> 3, h = item & 7, kvh = h >> 2;
            float q[64];
            { const v4u* qp = (const v4u*)(PROJ + (size_t)row * NIN + h * 64);
#pragma unroll
              for (int i = 0; i < 8; ++i) { const v4u w = qp[i]; const float c = 0.125f * 1.4426950408889634f;
                  q[8 * i + 0] = bflo(w.x) * c; q[8 * i + 1] = bfhi(w.x) * c; q[8 * i + 2] = bflo(w.y) * c; q[8 * i + 3] = bfhi(w.y) * c;
                  q[8 * i + 4] = bflo(w.z) * c; q[8 * i + 5] = bfhi(w.z) * c; q[8 * i + 6] = bflo(w.w) * c; q[8 * i + 7] = bfhi(w.w) * c; } }
            const float slope = exp2f(-(float)(h + 1)) * 1.4426950408889634f;
            float mx = sinks[h] * 1.4426950408889634f, l = 1.f; float o[64];
#pragma unroll
            for (int d = 0; d < 64; ++d) o[d] = 0.f;
#define ATT_DOT_BF(kr) do { _Pragma("unroll") for (int i = 0; i < 8; ++i) { const v4u w = ((const v4u*)(kr))[i]; \
                        sc += q[8 * i + 0] * bflo(w.x) + q[8 * i + 1] * bfhi(w.x) + q[8 * i + 2] * bflo(w.y) + q[8 * i + 3] * bfhi(w.y) \
                            + q[8 * i + 4] * bflo(w.z) + q[8 * i + 5] * bfhi(w.z) + q[8 * i + 6] * bflo(w.w) + q[8 * i + 7] * bfhi(w.w); } } while (0)
#define ATT_ACC_BF(vr) do { _Pragma("unroll") for (int i = 0; i < 8; ++i) { const v4u w = ((const v4u*)(vr))[i]; \
                        o[8 * i + 0] = o[8 * i + 0] * f + p * bflo(w.x); o[8 * i + 1] = o[8 * i + 1] * f + p * bfhi(w.x); o[8 * i + 2] = o[8 * i + 2] * f + p * bflo(w.y); o[8 * i + 3] = o[8 * i + 3] * f + p * bfhi(w.y); \
                        o[8 * i + 4] = o[8 * i + 4] * f + p * bflo(w.z); o[8 * i + 5] = o[8 * i + 5] * f + p * bfhi(w.z); o[8 * i + 6] = o[8 * i + 6] * f + p * bflo(w.w); o[8 * i + 7] = o[8 * i + 7] * f + p * bfhi(w.w); } } while (0)
#define ATT_SOFTMAX(rel) sc -= slope * (float)(rel); const float mn = fmaxf(mx, sc), f = __builtin_amdgcn_exp2f(mx - mn), p = __builtin_amdgcn_exp2f(sc - mn); l = l * f + p; mx = mn
            if (row < MP) {
                const int b = row >> 12, t = row & 4095, s0 = t > 128 ? t - 128 : 0;
                for (int s = s0; s <= t; ++s) {
                    const bf16* kr = PROJ + (size_t)(b * 4096 + s) * NIN + 512 + kvh * 64;
                    float sc = 0.f; ATT_DOT_BF(kr); ATT_SOFTMAX(t - s); ATT_ACC_BF(kr + 128);
                }
            } else {
                const int b = row - MP;
                for (int j = 0; j < 128; ++j) {
                    const f32x4* kr = (const f32x4*)(cache_k + ((size_t)(b * 128 + j) * 2 + kvh) * 64); const f32x4* vr = (const f32x4*)(cache_v + ((size_t)(b * 128 + j) * 2 + kvh) * 64);
                    float sc = 0.f;
#pragma unroll
                    for (int i = 0; i < 16; ++i) { const f32x4 w = kr[i]; sc += q[4 * i] * w.x + q[4 * i + 1] * w.y + q[4 * i + 2] * w.z + q[4 * i + 3] * w.w; }
                    ATT_SOFTMAX(128 - j);
#pragma unroll
                    for (int i = 0; i < 16; ++i) { const f32x4 w = vr[i]; o[4 * i] = o[4 * i] * f + p * w.x; o[4 * i + 1] = o[4 * i + 1] * f + p * w.y; o[4 * i + 2] = o[4 * i + 2] * f + p * w.z; o[4 * i + 3] = o[4 * i + 3] * f + p * w.w; }
                }
                { const bf16* kr = PROJ + (size_t)row * NIN + 512 + kvh * 64; float sc = 0.f; ATT_DOT_BF(kr); ATT_SOFTMAX(0); ATT_ACC_BF(kr + 128); }
            }
#undef ATT_DOT_BF
#undef ATT_ACC_BF
#undef ATT_SOFTMAX
            const float il = 1.f / l;
            v4u* op = (v4u*)(MIX + (size_t)row * DM + h * 64);
#pragma unroll
            for (int i = 0; i < 8; ++i) { v4u w; w.x = pk2(o[8 * i] * il, o[8 * i + 1] * il); w.y = pk2(o[8 * i + 2] * il, o[8 * i + 3] * il); w.z = pk2(o[8 * i + 4] * il, o[8 * i + 5] * il); w.w = pk2(o[8 * i + 6] * il, o[8 * i + 7] * il); op[i] = w; }
        }
        LAS float* ms = (LAS float*)(L + RING_OFF + wave * 4096);
        for (int item = gw; item < (MV / 8) * 4; item += NGW) {
            const int rt = item >> 2, g = item & 3, w = 2 << g;
#pragma unroll
            for (int r = 0; r < 8; ++r) {
                const int row = rt * 8 + r;
#pragma unroll
                for (int hf = 0; hf < 2; ++hf) {
                    const int cc = lane + 64 * hf, c = g * 128 + cc;
                    const bf16* up = PROJ + (size_t)row * NIN + 768 + c;
                    const float self = bf1(*up); float sum = self, cnt;
                    if (row < MP) { const int t = row & 4095, n = (w - 1) < t ? (w - 1) : t; for (int k = 1; k <= n; ++k) sum += bf1(*(up - (size_t)k * NIN)); cnt = (float)(n + 1); }
                    else { const int b = row - MP; for (int j = 16 - w; j <= 14; ++j) sum += state_pool[(size_t)(b * 15 + j) * 512 + c]; cnt = (float)w; }
                    ms[cc * 8 + r] = sum / cnt - self;
                }
            }
            LDS_WAIT(); asm volatile("" ::: "memory");
            float a0[8], a1[8];
#pragma unroll
            for (int r = 0; r < 8; ++r) { a0[r] = 0.f; a1[r] = 0.f; }
            const float* wp = w_pool + (size_t)g * 128 * 128;
            for (int c = 0; c < 128; ++c) {
                const float w0 = wp[c * 128 + lane], w1 = wp[c * 128 + 64 + lane];
                const f32x4 ma = *(const LAS f32x4*)(ms + c * 8), mb = *(const LAS f32x4*)(ms + c * 8 + 4);
                a0[0] += ma.x * w0; a0[1] += ma.y * w0; a0[2] += ma.z * w0; a0[3] += ma.w * w0; a0[4] += mb.x * w0; a0[5] += mb.y * w0; a0[6] += mb.z * w0; a0[7] += mb.w * w0;
                a1[0] += ma.x * w1; a1[1] += ma.y * w1; a1[2] += ma.z * w1; a1[3] += ma.w * w1; a1[4] += mb.x * w1; a1[5] += mb.y * w1; a1[6] += mb.z * w1; a1[7] += mb.w * w1;
            }
            const float s0 = pool_scale[g * 128 + lane], s1 = pool_scale[g * 128 + 64 + lane];
#pragma unroll
            for (int r = 0; r < 8; ++r) { bf16* mp = MIX + (size_t)(rt * 8 + r) * DM + 512 + g * 128; mp[lane] = (bf16)f2bf(a0[r] * s0); mp[64 + lane] = (bf16)f2bf(a1[r] * s1); }
            LDS_WAIT(); asm volatile("" ::: "memory");
        }
    }
    xcd_barrier(bar);

    {
        pg8::Gemm g{MIX, Wout_t, MPAD, DM, DM}; pg8::StaticOrder S; S.init(MPAD, DM, G, bx);
        pg8::EpiRes<true> E{x_p, x_s, out, XN, SS2};
        pg8::gemm_phase<pg8::EpiRes<true>, pg8::StaticOrder, true, true>(L + RING_OFF, g, S, E);
    }
    xcd_barrier(bar);

    {
        pg8::Gemm g{XN, Wgu_t, MPAD, 2 * DFF, DM}; pg8::StaticOrder S; S.init(MPAD, 2 * DFF, G, bx);
        pg8::EpiSwiGLU E{HB, SS2};
        pg8::gemm_phase<pg8::EpiSwiGLU, pg8::StaticOrder, true, true>(L + RING_OFF, g, S, E);
    }
    xcd_barrier(bar);

    {
        pg8::Gemm g{HB, Wd_t, MPAD, DM, DFF}; pg8::StaticOrder S; S.init(MPAD, DM, G, bx);
        pg8::EpiRes<false> E{nullptr, nullptr, out, nullptr, SS3};
        pg8::gemm_phase<pg8::EpiRes<false>, pg8::StaticOrder, true, true>(L + RING_OFF, g, S, E);
    }
    xcd_barrier(bar);

    {
        const unsigned poison = xb_ld((unsigned*)(ctl + CW_BAR) + XB_TMO);
        for (int m = gw; m < MV; m += NGW) {
            const f32x4* sp = (const f32x4*)(SS3 + (size_t)m * 16);
            const f32x4 a = (sp[0] + sp[1]) + (sp[2] + sp[3]);
            float rs = 1.0f / sqrtf(((a[0] + a[1]) + (a[2] + a[3])) * (1.0f / DM) + pg8::RMS_EPS);
            if (poison) rs = __builtin_nanf("");
            GAS f32x4* xr = (GAS f32x4*)(out + (size_t)m * DM) + lane; const f32x4* gf = (const f32x4*)final_norm + lane;
#pragma unroll
            for (int j = 0; j < 4; ++j) { const f32x4 v = xr[64 * j]; xr[64 * j] = v * rs * gf[64 * j]; }
        }
    }
}

extern "C" void kernel_launch(void* const* d_in, const int* in_sizes, int n_in, void* d_out, int out_size, void* d_ws, size_t ws_size, hipStream_t stream) {
    static int grid = 0;
    if (grid == 0) {
        if (n_in != 16 || out_size != (int)pg8::OUT_TOTAL || ws_size < WS_END) { fprintf(stderr, "kernel_launch: unexpected shapes (n_in %d, out %d, ws %zu); nothing launched\n", n_in, out_size, ws_size); grid = -1; return; }
        int dev = 0, cus = 0, per_cu = 0;
        if (hipGetDevice(&dev) != hipSuccess || hipDeviceGetAttribute(&cus, hipDeviceAttributeMultiprocessorCount, dev) != hipSuccess) { grid = -1; return; }
        if (hipFuncSetAttribute((const void*)hymba_fwd, hipFuncAttributeMaxDynamicSharedMemorySize, LDS_BYTES) != hipSuccess) { fprintf(stderr, "kernel_launch: hipFuncSetAttribute failed\n"); grid = -1; return; }
        if (hipOccupancyMaxActiveBlocksPerMultiprocessor(&per_cu, (const void*)hymba_fwd, NWAVES * 64, LDS_BYTES) != hipSuccess || per_cu < 1)
            fprintf(stderr, "kernel_launch: note: occupancy query reports %d workgroups per CU\n", per_cu);
        (void)hipGetLastError();
        grid = cus;
    }
    if (grid < 0) return;
    if (hipMemsetAsync((char*)d_ws + WS_CTL, 0, CTL_ZERO_BYTES, stream) != hipSuccess) { fprintf(stderr, "kernel_launch: hipMemsetAsync failed\n"); return; }
    Args a{};
    for (int i = 0; i < 16; ++i) a.in[i] = (const float*)d_in[i];
    a.out = (float*)d_out; a.ws = (unsigned char*)d_ws;
    hipLaunchKernelGGL(hymba_fwd, dim3(grid), dim3(NWAVES * 64), LDS_BYTES, stream, a);
}
```

```cpp
#include <hip/hip_runtime.h>
#include <cstdio>
#include <cstdint>
namespace pg8 {
#define PG8_LAS __attribute__((address_space(3)))
typedef unsigned short bf16_t;
typedef short bf16x8 __attribute__((ext_vector_type(8)));
typedef float f32x4 __attribute__((ext_vector_type(4)));
typedef unsigned u32x4 __attribute__((ext_vector_type(4)));
constexpr int BM = 256, BK = 64, HALF = 128, HTB = HALF * BK * 2  , STAGE_BYTES = 8 * HTB, NXCD = 8, WGM = 8;

__host__ __device__ __forceinline__ int lds_byte(int r, int c) { const int st = (r >> 4) * 2 + (c >> 5), rr = r & 15, cc = c & 31, ob = rr * 64 + cc * 2; return st * 1024 + (ob ^ (((ob >> 9) & 1) << 5)); }
__host__ __device__ __forceinline__ void stage_rc(int b, int& R, int& C) { const int st = b / 1024, sb = b % 1024, swz = sb ^ (((sb >> 9) & 1) << 5); R = (st >> 1) * 16 + swz / 64; C = (st & 1) * 32 + (swz % 64) / 2; }
__host__ __device__ __forceinline__ int perm32(int rho) { const int n = rho >> 4, i = rho & 15; return 8 * (i >> 2) + 4 * n + (i & 3); }

struct Unit { int pm, pn; };
struct Gemm { const bf16_t* A; const bf16_t* Bt; int M, N, K; };

struct StaticOrder {
    int nM, nN, nwg, G, c;
    __host__ __device__ void init(int M, int N, int G_, int c_) { nM = M / BM; nN = N / BM; nwg = nM * nN; G = G_; c = c_; }
    __host__ __device__ bool next(int i, Unit& u) const {
        const long L = (long)i * G + c; if (L >= nwg) return false;
        int wgid = (int)L; { const int q = nwg / NXCD, r = nwg % NXCD, xcd = wgid % NXCD, off = wgid / NXCD; wgid = (xcd < r ? xcd * (q + 1) : r * (q + 1) + (xcd - r) * q) + off; }
        const int nig = WGM * nN, gid = wgid / nig, fm = gid * WGM, gsz = (nM - fm) < WGM ? (nM - fm) : WGM;
        u.pm = fm + ((wgid % nig) % gsz); u.pn = (wgid % nig) / gsz; return true;
    }
    __device__ __forceinline__ void a_ready(const Unit&) const {}
    __device__ __forceinline__ void done(const Unit&) const {}
};

__device__ __forceinline__ unsigned cvt_pk_bf16(float lo, float hi) { unsigned r; asm volatile("v_cvt_pk_bf16_f32 %0, %1, %2" : "=v"(r) : "v"(lo), "v"(hi)); return r; }
typedef float f32x2 __attribute__((ext_vector_type(2)));

typedef unsigned u32x2 __attribute__((ext_vector_type(2)));
constexpr int ROWS_P = 16384, ROWS_V = 16512;
constexpr size_t OFF_Y = 0, OFF_KP = 16908288, OFF_VP = 16973824, OFF_PP = 17039360, OFF_KS = 17070080, OFF_VS = 19167232, OFF_PS = 21264384, OUT_TOTAL = 22247424;
constexpr float RMS_EPS = 1e-5f;

__device__ __forceinline__ float* side_dst(float* out, int row, int col) {
    if (row < ROWS_P) { const int b = row >> 12, t = row & 4095;
        if (col < 768) { if (t < 3968) return nullptr; const bool isv = col >= 640; return out + (isv ? OFF_VP : OFF_KP) + (size_t)((b * 128 + (t - 3968)) * 128 + (col - (isv ? 640 : 512))); }
        if (t < 4081) return nullptr; return out + OFF_PP + (size_t)((b * 15 + (t - 4081)) * 512 + (col - 768)); }
    if (row < ROWS_V) { const int b = row - ROWS_P;
        if (col < 768) { const bool isv = col >= 640; return out + (isv ? OFF_VS : OFF_KS) + (size_t)((b * 128 + 127) * 128 + (col - (isv ? 640 : 512))); }
        return out + OFF_PS + (size_t)((b * 15 + 14) * 512 + (col - 768)); }
    return nullptr;
}
struct EpiProj {
    static constexpr bool PERM = true, AFTER_DRAIN = false;
    bf16_t* P; const float* rstd; float* out;
    __device__ __forceinline__ void operator()(const f32x4 (&acc)[2][2][4][2], const Unit& u, int wr, int wc, int fr, int fq) const {
        const int col0 = u.pn * BM + wc * 32 + 8 * fq;
        const bool side = (u.pn >= 2) && (u.pm == 64 || (u.pm & 15) == 15);
#pragma unroll
        for (int ai = 0; ai < 2; ++ai)
#pragma unroll
            for (int m = 0; m < 4; ++m) {
                const int row = u.pm * BM + ai * HALF + wr * 64 + m * 16 + fr;
                const float rs = rstd[row];
                bf16_t* rowp = P + (size_t)row * 1280 + col0;
#pragma unroll
                for (int bj = 0; bj < 2; ++bj) {
                    const f32x4 v0 = acc[ai][bj][m][0] * rs, v1 = acc[ai][bj][m][1] * rs;
                    u32x4 w; w.x = cvt_pk_bf16(v0[0], v0[1]); w.y = cvt_pk_bf16(v0[2], v0[3]); w.z = cvt_pk_bf16(v1[0], v1[1]); w.w = cvt_pk_bf16(v1[2], v1[3]);
                    *(u32x4*)(rowp + bj * HALF) = w;
                    if (side) { float* d = side_dst(out, row, col0 + bj * HALF); if (d) { *(f32x4*)d = v0; *(f32x4*)(d + 4) = v1; } }
                }
            }
    }
};
template <bool FIRST> struct EpiRes {
    static constexpr bool PERM = false, AFTER_DRAIN = false;
    const float* xp; const float* xs; float* out; bf16_t* XN; float* SS;
    __device__ __forceinline__ void operator()(const f32x4 (&acc)[2][2][4][2], const Unit& u, int wr, int wc, int fr, int fq) const {
        const int col0 = u.pn * BM + wc * 32 + 4 * fq;
#pragma unroll
        for (int ai = 0; ai < 2; ++ai)
#pragma unroll
            for (int m = 0; m < 4; ++m) {
                const int row = u.pm * BM + ai * HALF + wr * 64 + m * 16 + fr;
                if (row < ROWS_V) {
                    float* orow = out + (size_t)row * 1024 + col0;
                    const float* xr = FIRST ? ((row < ROWS_P) ? xp + (size_t)row * 1024 : xs + (size_t)(row - ROWS_P) * 1024) + col0 : orow;
                    float ss = 0.f;
#pragma unroll
                    for (int bj = 0; bj < 2; ++bj)
#pragma unroll
                        for (int n = 0; n < 2; ++n) {
                            const int c = bj * HALF + n * 16;
                            const f32x4 v = *(const f32x4*)(xr + c) + acc[ai][bj][m][n];
                            *(f32x4*)(orow + c) = v;
                            if (FIRST) { u32x2 w; w.x = cvt_pk_bf16(v[0], v[1]); w.y = cvt_pk_bf16(v[2], v[3]); *(u32x2*)(XN + (size_t)row * 1024 + col0 + c) = w; }
                            ss += (v[0] * v[0] + v[1] * v[1]) + (v[2] * v[2] + v[3] * v[3]);
                        }
                    ss += __shfl_xor(ss, 16); ss += __shfl_xor(ss, 32);
                    if (fq == 0) SS[(size_t)row * 16 + u.pn * 4 + wc] = ss;
                }
            }
    }
};
struct EpiSwiGLU {
    static constexpr bool PERM = true, AFTER_DRAIN = false;
    bf16_t* H; const float* SS;
    __device__ __forceinline__ void operator()(const f32x4 (&acc)[2][2][4][2], const Unit& u, int wr, int wc, int fr, int fq) const {
        const int colh = u.pn * HALF + wc * 32 + 8 * fq;
#pragma unroll
        for (int ai = 0; ai < 2; ++ai)
#pragma unroll
            for (int m = 0; m < 4; ++m) {
                const int row = u.pm * BM + ai * HALF + wr * 64 + m * 16 + fr;
                const f32x4* sp = (const f32x4*)(SS + (size_t)row * 16);
                const f32x4 a = (sp[0] + sp[1]) + (sp[2] + sp[3]);
                const float rs = 1.0f / sqrtf(((a[0] + a[1]) + (a[2] + a[3])) * (1.0f / 1024.0f) + RMS_EPS);
                float hv[8];
#pragma unroll
                for (int n = 0; n < 2; ++n)
#pragma unroll
                    for (int j = 0; j < 4; ++j) {
                        const float g = acc[ai][0][m][n][j] * rs, uu = acc[ai][1][m][n][j] * rs;
                        const float sg = g * __builtin_amdgcn_rcpf(1.0f + __builtin_amdgcn_exp2f(-1.4426950408889634f * g));
                        hv[n * 4 + j] = sg * uu;
                    }
                u32x4 w; w.x = cvt_pk_bf16(hv[0], hv[1]); w.y = cvt_pk_bf16(hv[2], hv[3]); w.z = cvt_pk_bf16(hv[4], hv[5]); w.w = cvt_pk_bf16(hv[6], hv[7]);
                *(u32x4*)(H + (size_t)row * 2816 + colh) = w;
            }
    }
};

template <class Epi, class Sched, bool ALIGN_EPI = false, bool SP2 = false>
__device__ __forceinline__ void gemm_phase(PG8_LAS unsigned char* lds, const Gemm g, const Sched& S, const Epi& E) {
    const int tid = threadIdx.x, wid = __builtin_amdgcn_readfirstlane(tid >> 6), lane = tid & 63, wr = wid >> 2, wc = wid & 3, fr = lane & 15, fq = lane >> 4;
    const int K = g.K, nt = K / BK;
    unsigned voffA[2], voffB[2];
#pragma unroll
    for (int i = 0; i < 2; ++i) { int R, C; stage_rc(tid * 16 + i * 8192, R, C); const int Rb = Epi::PERM ? ((R & ~31) + perm32(R & 31)) : R;
        voffA[i] = (unsigned)(R * K + C) * 2u; voffB[i] = (unsigned)(Rb * K + C) * 2u; }
    const size_t kstep = (size_t)(BK * 2);
    const size_t hstep = (size_t)HALF * K * 2;
    const size_t tstep = 2 * hstep;
    const unsigned ldsw = (unsigned)wid * 1024u;
    const int aoff = lds_byte(wr * 64 + fr, fq * 8), boff = lds_byte(wc * 32 + fr, fq * 8);
#define PG8_SA(b, h) (((b) * 2 + (h)) * HTB)
#define PG8_SB(b, h) ((4 + (b) * 2 + (h)) * HTB)
#define PG8_STAGE(bufoff, gbase, voff) do { _Pragma("unroll") for (int _i = 0; _i < 2; ++_i) \
        __builtin_amdgcn_global_load_lds((const unsigned*)((const char*)(gbase) + (voff)[_i]), (PG8_LAS unsigned*)(lds + (bufoff) + ldsw + _i * 8192), 16, 0, 0); } while (0)
#define PG8_LDA(dst, b, h) do { _Pragma("unroll") for (int m = 0; m < 4; ++m) _Pragma("unroll") for (int k = 0; k < 2; ++k) dst[m][k] = *(const PG8_LAS bf16x8*)(lds + PG8_SA(b, h) + aoff + m * 2048 + k * 1024); } while (0)
#define PG8_LDB(dst, b, h) do { _Pragma("unroll") for (int n = 0; n < 2; ++n) _Pragma("unroll") for (int k = 0; k < 2; ++k) dst[n][k] = *(const PG8_LAS bf16x8*)(lds + PG8_SB(b, h) + boff + n * 2048 + k * 1024); } while (0)
#define PG8_MMA(ai, bj, At, Bt) do { __builtin_amdgcn_s_setprio(1); _Pragma("unroll") for (int m = 0; m < 4; ++m) _Pragma("unroll") for (int n = 0; n < 2; ++n) _Pragma("unroll") for (int k = 0; k < 2; ++k) \
        acc[ai][bj][m][n] = __builtin_amdgcn_mfma_f32_16x16x32_bf16(Bt[n][k], At[m][k], acc[ai][bj][m][n], 0, 0, 0); __builtin_amdgcn_s_setprio(0); } while (0)
#define PG8_WAIT_V(n) asm volatile("s_waitcnt vmcnt(" #n ")" ::: "memory")
#define PG8_WAIT_L(n) asm volatile("s_waitcnt lgkmcnt(" #n ")" ::: "memory")
#define PG8_BAR __builtin_amdgcn_s_barrier()
#define PG8_SCHED __builtin_amdgcn_sched_barrier(0)
    Unit cur, nxt; int ui = 0;
    if (!S.next(0, cur)) return;
    f32x4 acc[2][2][4][2];
#pragma unroll
    for (int a = 0; a < 2; ++a)
#pragma unroll
        for (int b = 0; b < 2; ++b)
#pragma unroll
            for (int m = 0; m < 4; ++m)
#pragma unroll
                for (int n = 0; n < 2; ++n) acc[a][b][m][n] = (f32x4){0.f, 0.f, 0.f, 0.f};
    bf16x8 At[4][2], B0[2][2], B1[2][2];
    const char* cA = (const char*)g.A + (size_t)cur.pm * tstep; const char* cB = (const char*)g.Bt + (size_t)cur.pn * tstep;
    S.a_ready(cur);
    if constexpr (SP2) {
        PG8_STAGE(PG8_SB(0, 0), cB, voffB); PG8_STAGE(PG8_SB(0, 1), cB + hstep, voffB); PG8_STAGE(PG8_SA(0, 0), cA, voffA); PG8_STAGE(PG8_SA(0, 1), cA + hstep, voffA);
        if (wr == 1) PG8_BAR;
        PG8_WAIT_V(2); PG8_BAR;
        PG8_STAGE(PG8_SB(1, 0), cB + kstep, voffB); PG8_STAGE(PG8_SA(1, 0), cA + kstep, voffA); PG8_STAGE(PG8_SB(1, 1), cB + hstep + kstep, voffB);
        PG8_WAIT_V(6); PG8_BAR;
    } else {
        PG8_STAGE(PG8_SB(0, 0), cB, voffB); PG8_STAGE(PG8_SA(0, 0), cA, voffA); PG8_STAGE(PG8_SB(0, 1), cB + hstep, voffB); PG8_STAGE(PG8_SA(0, 1), cA + hstep, voffA);
        if (wr == 1) PG8_BAR;
        PG8_WAIT_V(4); PG8_BAR;
        PG8_STAGE(PG8_SB(1, 0), cB + kstep, voffB); PG8_STAGE(PG8_SA(1, 0), cA + kstep, voffA); PG8_STAGE(PG8_SB(1, 1), cB + hstep + kstep, voffB);
        PG8_WAIT_V(6); PG8_BAR;
    }
    for (;;) {
        const bool has_next = S.next(ui + 1, nxt);
        const char* nA = has_next ? (const char*)g.A + (size_t)nxt.pm * tstep : cA; const char* nB = has_next ? (const char*)g.Bt + (size_t)nxt.pn * tstep : cB;
        for (int t = 0; t < nt; t += 2) {
            const bool last = (t == nt - 2);
            const char* a1 = cA + (size_t)(t + 1) * kstep;
            const char* a2 = last ? nA : cA + (size_t)(t + 2) * kstep; const char* b2 = last ? nB : cB + (size_t)(t + 2) * kstep;
            const char* a3 = a2 + kstep; const char* b3 = b2 + kstep;
            if (last && has_next) S.a_ready(nxt);
            if constexpr (SP2) {
            PG8_LDB(B0, 0, 0); PG8_LDB(B1, 0, 1); PG8_SCHED; PG8_LDA(At, 0, 0); PG8_STAGE(PG8_SA(1, 1), a1 + hstep, voffA);
            PG8_WAIT_V(8); PG8_WAIT_L(0); PG8_BAR; PG8_MMA(0, 0, At, B0); PG8_MMA(0, 1, At, B1); PG8_BAR; PG8_SCHED;
            PG8_LDA(At, 0, 1); PG8_STAGE(PG8_SB(0, 0), b2, voffB); PG8_STAGE(PG8_SB(0, 1), b2 + hstep, voffB); PG8_STAGE(PG8_SA(0, 0), a2, voffA);
            PG8_WAIT_V(8); PG8_WAIT_L(0); PG8_BAR; PG8_MMA(1, 0, At, B0); PG8_MMA(1, 1, At, B1); PG8_BAR; PG8_SCHED;
            PG8_LDB(B0, 1, 0); PG8_LDB(B1, 1, 1); PG8_SCHED; PG8_LDA(At, 1, 0); PG8_STAGE(PG8_SA(0, 1), a2 + hstep, voffA);
            PG8_WAIT_V(8); PG8_WAIT_L(0); PG8_BAR; PG8_MMA(0, 0, At, B0); PG8_MMA(0, 1, At, B1); PG8_BAR; PG8_SCHED;
            PG8_LDA(At, 1, 1); PG8_STAGE(PG8_SB(1, 0), b3, voffB); PG8_STAGE(PG8_SB(1, 1), b3 + hstep, voffB); PG8_STAGE(PG8_SA(1, 0), a3, voffA);
            PG8_WAIT_V(8); PG8_WAIT_L(0); PG8_BAR; PG8_MMA(1, 0, At, B0); PG8_MMA(1, 1, At, B1); PG8_BAR; PG8_SCHED;
            } else {
            PG8_LDB(B0, 0, 0); PG8_SCHED; PG8_LDA(At, 0, 0); PG8_STAGE(PG8_SA(1, 1), a1 + hstep, voffA);
            PG8_WAIT_L(8); PG8_BAR; PG8_WAIT_L(0); PG8_MMA(0, 0, At, B0); PG8_BAR; PG8_SCHED;
            PG8_LDB(B1, 0, 1); PG8_STAGE(PG8_SB(0, 0), b2, voffB);
            PG8_BAR; PG8_WAIT_L(0); PG8_MMA(0, 1, At, B1); PG8_BAR;
            PG8_LDA(At, 0, 1); PG8_STAGE(PG8_SA(0, 0), a2, voffA);
            PG8_BAR; PG8_WAIT_L(0); PG8_MMA(1, 0, At, B0); PG8_BAR; PG8_SCHED;
            PG8_STAGE(PG8_SB(0, 1), b2 + hstep, voffB);
            PG8_WAIT_V(6); PG8_BAR; PG8_MMA(1, 1, At, B1); PG8_BAR;
            PG8_LDB(B0, 1, 0); PG8_SCHED; PG8_LDA(At, 1, 0); PG8_STAGE(PG8_SA(0, 1), a2 + hstep, voffA);
            PG8_WAIT_L(8); PG8_BAR; PG8_WAIT_L(0); PG8_MMA(0, 0, At, B0); PG8_BAR; PG8_SCHED;
            PG8_LDB(B1, 1, 1); PG8_STAGE(PG8_SB(1, 0), b3, voffB);
            PG8_BAR; PG8_WAIT_L(0); PG8_MMA(0, 1, At, B1); PG8_BAR;
            PG8_LDA(At, 1, 1); PG8_STAGE(PG8_SA(1, 0), a3, voffA);
            PG8_BAR; PG8_WAIT_L(0); PG8_MMA(1, 0, At, B0); PG8_BAR; PG8_SCHED;
            PG8_STAGE(PG8_SB(1, 1), b3 + hstep, voffB);
            PG8_WAIT_V(6); PG8_BAR; PG8_MMA(1, 1, At, B1); PG8_BAR;
            }
        }
        if constexpr (ALIGN_EPI) { if (wr == 0) PG8_BAR; }
        if constexpr (!Epi::AFTER_DRAIN) { E(acc, cur, wr, wc, fr, fq); S.done(cur); }
        if (!has_next) break;
#pragma unroll
        for (int a = 0; a < 2; ++a)
#pragma unroll
            for (int b = 0; b < 2; ++b)
#pragma unroll
                for (int m = 0; m < 4; ++m)
#pragma unroll
                    for (int n = 0; n < 2; ++n) acc[a][b][m][n] = (f32x4){0.f, 0.f, 0.f, 0.f};
        cur = nxt; cA = nA; cB = nB; ++ui;
        if constexpr (ALIGN_EPI) { if (wr == 1) PG8_BAR; }
    }
    PG8_WAIT_V(0);
    if constexpr (!ALIGN_EPI) { if (wr == 0) PG8_BAR; }
    PG8_BAR;
    if constexpr (Epi::AFTER_DRAIN) { E.fused(acc, cur, wr, wc, fr, fq, lds, wid, lane); S.done(cur); }
#undef PG8_SA
#undef PG8_SB
#undef PG8_STAGE
#undef PG8_LDA
#undef PG8_LDB
#undef PG8_MMA
#undef PG8_WAIT_V
#undef PG8_WAIT_L
#undef PG8_BAR
#undef PG8_SCHED
}
}
#define GAS __attribute__((address_space(1)))
#define LAS __attribute__((address_space(3)))
typedef unsigned short bf16;
typedef unsigned v4u __attribute__((ext_vector_type(4)));
typedef float f32x4 __attribute__((ext_vector_type(4)));
typedef short bf16x8 __attribute__((ext_vector_type(8)));
typedef GAS unsigned gu32;
typedef GAS unsigned long long gu64;
#define RLX_AGENT __ATOMIC_RELAXED, __HIP_MEMORY_SCOPE_AGENT
#define LDS_WAIT() asm volatile("s_waitcnt lgkmcnt(0)" ::: "memory")
#define VM_WAIT() asm volatile("s_waitcnt vmcnt(0)" ::: "memory")
__device__ __forceinline__ unsigned long long rt() { return __builtin_amdgcn_s_memrealtime(); }
__device__ __forceinline__ unsigned f2bf(float f) { unsigned u = __builtin_bit_cast(unsigned, f); return (u + 0x7fffu + ((u >> 16) & 1u)) >> 16; }
__device__ __forceinline__ unsigned pk2(float lo, float hi) { return f2bf(lo) | (f2bf(hi) << 16); }

#define XB_TMO      128
#define XB_XCNT(j)  (256  + 64 * (j))
#define XB_XSUB(j)  (1280 + 64 * (j))
#define XB_XGEN(j)  (2304 + 64 * (j))
#define XB_TOP      3328
#define XB_TOPGEN   3392
#define XCD_BAR_WORDS 3456
#define XB_SPIN_CAP (1u << 18)

__device__ __forceinline__ unsigned xb_ld(unsigned* p)              { return __hip_atomic_load(p, __ATOMIC_RELAXED, __HIP_MEMORY_SCOPE_AGENT); }
__device__ __forceinline__ unsigned xb_add(unsigned* p, unsigned v) { return __hip_atomic_fetch_add(p, v, __ATOMIC_RELAXED, __HIP_MEMORY_SCOPE_AGENT); }
__device__ __forceinline__ unsigned xb_xcc_id() { return (unsigned)__builtin_amdgcn_s_getreg((3 << 11) | 20) & 0xFu; }
#define XB_SPIN(cond, bar) do { unsigned _sp = 0; while (cond) { __builtin_amdgcn_s_sleep(1); \
    if ((++_sp & 255u) == 0u) { if (xb_ld(&(bar)[XB_TMO])) break; if (_sp > XB_SPIN_CAP) { atomicAdd(&(bar)[XB_TMO], 1u); break; } } } } while (0)

struct XcdBarrier {
    unsigned* bar; unsigned x;
    volatile LAS unsigned* st;
};

__device__ __forceinline__ XcdBarrier xcd_barrier_post(unsigned* bar, volatile LAS unsigned* st) {
    XcdBarrier b; b.bar = bar; b.x = xb_xcc_id(); b.st = st;
    if (threadIdx.x == 0) (void)xb_add(&bar[XB_XCNT(b.x)], 1u);
    return b;
}
__device__ __forceinline__ void xcd_barrier_complete(unsigned* bar, unsigned x, unsigned& nloc, unsigned& nx) {
    const unsigned G = gridDim.x * gridDim.y * gridDim.z;
    unsigned sum, cnt, mine, sp = 0u;
    for (;;) {
        sum = 0u; cnt = 0u; mine = 0u;
#pragma unroll
        for (unsigned j = 0; j < 16; ++j) { const unsigned c = xb_ld(&bar[XB_XCNT(j)]); sum += c; cnt += (c > 0u) ? 1u : 0u; mine = (j == x) ? c : mine; }
        if (sum == G) break;
        __builtin_amdgcn_s_sleep(1);
        if ((++sp & 255u) == 0u) { if (xb_ld(&bar[XB_TMO])) break; if (sp > XB_SPIN_CAP) { atomicAdd(&bar[XB_TMO], 1u); break; } }
    }
    nloc = mine > 0u ? mine : 1u; nx = cnt > 0u ? cnt : 1u;
}

__device__ __forceinline__ void xcd_barrier(const XcdBarrier& b) {
    asm volatile("s_waitcnt vmcnt(0)" ::: "memory");
    __syncthreads();
    if (threadIdx.x == 0) {
        unsigned* bar = b.bar;
        __builtin_amdgcn_s_waitcnt(0);
        unsigned nloc = b.st[0], nx = b.st[1];
        if (nloc == 0u) { xcd_barrier_complete(bar, b.x, nloc, nx); b.st[0] = nloc; b.st[1] = nx; }
        const unsigned old = xb_add(&bar[XB_XSUB(b.x)], 1u);
        const unsigned gen = old / nloc;
        if (old + 1u == (gen + 1u) * nloc) {
            __builtin_amdgcn_fence(__ATOMIC_RELEASE, "agent");
            asm volatile("s_waitcnt vmcnt(0)" ::: "memory");
            const unsigned og = xb_add(&bar[XB_TOP], 1u);
            const unsigned tg = og / nx;
            if (og + 1u == (tg + 1u) * nx) xb_add(&bar[XB_TOPGEN], 1u);
            else XB_SPIN(xb_ld(&bar[XB_TOPGEN]) == tg, bar);
            __builtin_amdgcn_fence(__ATOMIC_ACQUIRE, "agent");
            xb_add(&bar[XB_XGEN(b.x)], 1u);
            asm volatile("s_waitcnt vmcnt(0)" ::: "memory");
        } else {
            XB_SPIN(xb_ld(&bar[XB_XGEN(b.x)]) == gen, bar);
            __builtin_amdgcn_fence(__ATOMIC_ACQUIRE, "agent");
            asm volatile("s_waitcnt vmcnt(0)" ::: "memory");
        }
    }
    __syncthreads();
}

constexpr int NWAVES = 8;
constexpr int DM = 1024, MP = 16384, MSMP = 128, MV = 16512, MPAD = 16640, NIN = 1280, DFF = 2816;
constexpr size_t MiB = 1u << 20;
constexpr size_t WS_CTL = 0, CTL_ZERO_BYTES = 65536;
constexpr size_t WS_RSTD = 1 * MiB;
constexpr size_t WS_SS2 = 2 * MiB, WS_SS3 = 4 * MiB;
constexpr size_t WS_WIN = 6 * MiB, WS_WOUT = 9 * MiB, WS_WGU = 11 * MiB, WS_WD = 22 * MiB;
constexpr size_t WS_XN = 28 * MiB;
constexpr size_t WS_PROJ = 61 * MiB;
constexpr size_t WS_MIX = 102 * MiB;
constexpr size_t WS_H = 135 * MiB;
constexpr size_t WS_END = 225 * MiB;
static_assert(WS_WIN + (size_t)NIN * DM * 2 <= WS_WOUT && WS_WGU + (size_t)2 * DFF * DM * 2 <= WS_WD && WS_WD + (size_t)DM * DFF * 2 <= WS_XN, "ws map: weights");
static_assert(WS_XN + (size_t)MPAD * DM * 2 <= WS_PROJ && WS_PROJ + (size_t)MPAD * NIN * 2 <= WS_MIX && WS_MIX + (size_t)MPAD * DM * 2 <= WS_H && WS_H + (size_t)MPAD * DFF * 2 <= WS_END, "ws map: activations");
static_assert(WS_SS2 + (size_t)MPAD * 64 <= WS_SS3 && WS_SS3 + (size_t)MPAD * 64 <= WS_WIN, "ws map: stats");
constexpr int CW_BAR = 4096;
static_assert((CW_BAR + XCD_BAR_WORDS) * 4 <= (int)CTL_ZERO_BYTES, "barrier words inside the memset region");
constexpr int RING_OFF = 0, RING_BYTES = 131072, LDSCTL_OFF = RING_BYTES, MISC_OFF = LDSCTL_OFF + 320, LDS_BYTES = 147456;

__device__ __forceinline__ float wave_sum(float v) {
#pragma unroll
    for (int o = 1; o < 64; o <<= 1) v += __shfl_xor(v, o);
    return v;
}
__device__ __forceinline__ float bflo(unsigned w) { return __builtin_bit_cast(float, w << 16); }
__device__ __forceinline__ float bfhi(unsigned w) { return __builtin_bit_cast(float, w & 0xffff0000u); }
__device__ __forceinline__ float bf1(bf16 b) { return __builtin_bit_cast(float, (unsigned)b << 16); }

template <int MODE>
__device__ __forceinline__ void p0_transpose_item(const float* W, int K, int N, const float* gain, bf16* WT, LAS float* scr, int item, int lane) {
    const int nblk = N / 32, kb = item / nblk, nb = item % nblk, k0 = 64 * kb, n0 = 32 * nb;
#pragma unroll 8
    for (int i = 0; i < 32; ++i) { const int kk = 2 * i + (lane >> 5); float w = W[(size_t)(k0 + kk) * N + n0 + (lane & 31)]; if (gain) w *= gain[k0 + kk]; scr[kk * 33 + (lane & 31)] = w; }
    LDS_WAIT(); asm volatile("" ::: "memory");
    const int c = lane & 7;
#pragma unroll
    for (int j = 0; j < 4; ++j) { const int n = (lane >> 3) + 8 * j; const LAS float* s = scr + (8 * c) * 33 + n;
        v4u o; o.x = pk2(s[0 * 33], s[1 * 33]); o.y = pk2(s[2 * 33], s[3 * 33]); o.z = pk2(s[4 * 33], s[5 * 33]); o.w = pk2(s[6 * 33], s[7 * 33]);
        const int nn = n0 + n, orow = (MODE == 0) ? nn : ((nn >> 7) * 256 + (MODE == 2 ? 128 : 0) + (nn & 127));
        *(GAS v4u*)(WT + (size_t)orow * K + k0 + 8 * c) = o; }
    LDS_WAIT(); asm volatile("" ::: "memory");
}


typedef float f32x16 __attribute__((ext_vector_type(16)));
typedef unsigned short u16x8 __attribute__((ext_vector_type(8)));
__device__ __forceinline__ unsigned cvtpk(float lo, float hi) { typedef float f2_t __attribute__((ext_vector_type(2))); typedef __bf16 b2_t __attribute__((ext_vector_type(2)));
    f2_t v = {lo, hi}; b2_t b = __builtin_convertvector(v, b2_t); return __builtin_bit_cast(unsigned, b); }
__device__ __forceinline__ bf16x8 pack8(float a0, float a1, float a2, float a3, float a4, float a5, float a6, float a7) {
    v4u w; w.x = cvtpk(a0, a1); w.y = cvtpk(a2, a3); w.z = cvtpk(a4, a5); w.w = cvtpk(a6, a7); return __builtin_bit_cast(bf16x8, w); }
constexpr float LOG2E = 1.4426950408889634f;

template <bool SAMPLE>
__device__ __forceinline__ void attn_unit(const bf16* PROJ, const float* cache_k, const float* cache_v, const float* sinks, bf16* MIX, LAS unsigned char* vst, int b, int kvh, int qb, int lane) {
    const int r = lane & 31, hh = lane >> 5;
    const int nskip = SAMPLE ? 0 : (qb < 4 ? 4 - qb : 0);
    const size_t R0 = SAMPLE ? 0 : (size_t)b * 4096; const int q0 = qb * 32;
    const size_t srow = (size_t)MP + b;
    const bf16x8 zero8 = {0, 0, 0, 0, 0, 0, 0, 0};
#pragma unroll 2
    for (int it = 0; it < 20; ++it) {
        const int rr = 8 * it + (lane >> 3), c = lane & 7;
        v4u w = {0u, 0u, 0u, 0u};
        if (!SAMPLE) { if (it >= 4 * nskip) w = *(const v4u*)(PROJ + (R0 + q0 - 128 + rr) * NIN + 640 + kvh * 64 + 8 * c); }
        else if (it < 16) { const f32x4* vp = (const f32x4*)(cache_v + ((size_t)(b * 128 + rr) * 2 + kvh) * 64 + 8 * c); const f32x4 a = vp[0], d = vp[1];
            w.x = cvtpk(a[0], a[1]); w.y = cvtpk(a[2], a[3]); w.z = cvtpk(d[0], d[1]); w.w = cvtpk(d[2], d[3]); }
        else if (it == 16) { const v4u vn = *(const v4u*)(PROJ + srow * NIN + 640 + kvh * 64 + 8 * c); if (rr == 128) w = vn; }
        *(LAS v4u*)(vst + rr * 128 + c * 16) = w;
    }
    const LAS unsigned short* vrd = (const LAS unsigned short*)(vst + (4 * hh) * 128 + r * 2);
    constexpr int NG = SAMPLE ? 1 : 4;
#pragma unroll 1
    for (int g = 0; g < NG; ++g) {
        const int head = kvh * 4 + (SAMPLE ? (r & 3) : g);
        const bool colok = !SAMPLE || r < 4;
        bf16x8 qf[4];
        { const bf16* qp = PROJ + (SAMPLE ? srow : R0 + q0 + r) * NIN + head * 64 + 8 * hh;
#pragma unroll
          for (int ds = 0; ds < 4; ++ds) qf[ds] = colok ? *(const bf16x8*)(qp + 16 * ds) : zero8; }
        const float slope2 = __builtin_amdgcn_exp2f(-(float)(head + 1)) * LOG2E, sink2 = sinks[head] * LOG2E;
        float mx = sink2, lh = 0.f;
        f32x16 O[2];
#pragma unroll
        for (int k = 0; k < 16; ++k) { O[0][k] = 0.f; O[1][k] = 0.f; }
        const int rb = SAMPLE ? -4 * hh : r - 4 * hh;
#pragma unroll 1
        for (int i = nskip; i < 5; ++i) {
            f32x16 S;
#pragma unroll
            for (int k = 0; k < 16; ++k) S[k] = 0.f;
            if (!SAMPLE || i < 4) {
                const bf16* kpb = PROJ + (R0 + q0 - 128 + 32 * i + r) * NIN + 512 + kvh * 64 + 8 * hh;
                const float* kpf = cache_k + ((size_t)(b * 128 + 32 * i + r) * 2 + kvh) * 64 + 8 * hh;
#pragma unroll
                for (int ds = 0; ds < 4; ++ds) {
                    bf16x8 kf;
                    if (!SAMPLE) kf = *(const bf16x8*)(kpb + 16 * ds);
                    else { const f32x4 a = *(const f32x4*)(kpf + 16 * ds), c = *(const f32x4*)(kpf + 16 * ds + 4); kf = pack8(a[0], a[1], a[2], a[3], c[0], c[1], c[2], c[3]); }
                    S = __builtin_amdgcn_mfma_f32_32x32x16_bf16(kf, qf[ds], S, 0, 0, 0);
                }
            } else {
#pragma unroll
                for (int ds = 0; ds < 4; ++ds) {
                    const bf16x8 kn = *(const bf16x8*)(PROJ + srow * NIN + 512 + kvh * 64 + 16 * ds + 8 * hh); const bf16x8 kf = (r == 0) ? kn : zero8;
                    S = __builtin_amdgcn_mfma_f32_32x32x16_bf16(kf, qf[ds], S, 0, 0, 0);
                }
            }
            const int relb = 128 - 32 * i + rb;
            float tm = -1e30f;
#pragma unroll
            for (int k = 0; k < 16; ++k) {
                const int rel = relb - ((k & 3) + 8 * (k >> 2));
                const bool valid = SAMPLE ? (rel >= 0) : ((unsigned)rel <= 128u);
                const float sc = valid ? S[k] * (0.125f * LOG2E) - slope2 * (float)rel : -1e30f;
                S[k] = sc; tm = fmaxf(tm, sc);
            }
            tm = fmaxf(tm, __shfl_xor(tm, 32));
            const float mn = fmaxf(mx, tm), alpha = __builtin_amdgcn_exp2f(mx - mn); mx = mn;
            float ps = 0.f;
#pragma unroll
            for (int k = 0; k < 16; ++k) { const float p = __builtin_amdgcn_exp2f(S[k] - mn); S[k] = p; ps += p; }
            lh = lh * alpha + ps;
#pragma unroll
            for (int k = 0; k < 16; ++k) { O[0][k] *= alpha; O[1][k] *= alpha; }
            const LAS unsigned short* vt = vrd + i * 2048;
#pragma unroll
            for (int s = 0; s < 2; ++s) {
                const bf16x8 pf = pack8(S[8 * s + 0], S[8 * s + 1], S[8 * s + 2], S[8 * s + 3], S[8 * s + 4], S[8 * s + 5], S[8 * s + 6], S[8 * s + 7]);
#pragma unroll
                for (int db = 0; db < 2; ++db) {
                    u16x8 e;
#pragma unroll
                    for (int j = 0; j < 8; ++j) e[j] = vt[(16 * s + 8 * (j >> 2) + (j & 3)) * 64 + 32 * db];
                    O[db] = __builtin_amdgcn_mfma_f32_32x32x16_bf16(__builtin_bit_cast(bf16x8, e), pf, O[db], 0, 0, 0);
                }
            }
        }
        const float l = lh + __shfl_xor(lh, 32) + __builtin_amdgcn_exp2f(sink2 - mx);
        const float il = 1.0f / l;
        if (colok) {
            bf16* op = MIX + (SAMPLE ? srow : R0 + q0 + r) * DM + head * 64 + 4 * hh;
#pragma unroll
            for (int db = 0; db < 2; ++db)
#pragma unroll
                for (int k4 = 0; k4 < 4; ++k4) { pg8::u32x2 w; w.x = cvtpk(O[db][4 * k4] * il, O[db][4 * k4 + 1] * il); w.y = cvtpk(O[db][4 * k4 + 2] * il, O[db][4 * k4 + 3] * il);
                    *(pg8::u32x2*)(op + 32 * db + 8 * k4) = w; }
        }
    }
}
struct Args { const float* in[16]; float* out; unsigned char* ws; };

__global__ void __launch_bounds__(NWAVES * 64, 2) hymba_fwd(Args args) {
    extern __shared__ __attribute__((aligned(16))) unsigned char lds[];
    LAS unsigned char* const L = (LAS unsigned char*)lds;
    volatile LAS unsigned* const MISC = (volatile LAS unsigned*)(L + MISC_OFF);
    const int tid = threadIdx.x, lane = tid & 63, wave = __builtin_amdgcn_readfirstlane(tid >> 6);
    const int G = gridDim.x; const int bx = blockIdx.x; const int vcu = (G % 8 == 0) ? (bx % 8) * (G / 8) + bx / 8 : bx;
    const int gw = vcu * NWAVES + wave, NGW = G * NWAVES;
    unsigned char* const ws = args.ws;
    const float* const x_p = args.in[0]; const float* const x_s = args.in[1]; const float* const cache_k = args.in[2]; const float* const cache_v = args.in[3];
    const float* const state_pool = args.in[4]; const float* const norm1 = args.in[5]; const float* const w_in = args.in[6]; const float* const sinks = args.in[7];
    const float* const w_pool = args.in[8]; const float* const pool_scale = args.in[9]; const float* const w_out = args.in[10]; const float* const norm2 = args.in[11];
    const float* const w_gate = args.in[12]; const float* const w_up = args.in[13]; const float* const w_down = args.in[14]; const float* const final_norm = args.in[15];
    float* const out = args.out;
    gu32* const ctl = (gu32*)(ws + WS_CTL);
    float* const RSTD = (float*)(ws + WS_RSTD); float* const SS2 = (float*)(ws + WS_SS2); float* const SS3 = (float*)(ws + WS_SS3);
    bf16* const Win_t = (bf16*)(ws + WS_WIN); bf16* const Wout_t = (bf16*)(ws + WS_WOUT); bf16* const Wgu_t = (bf16*)(ws + WS_WGU); bf16* const Wd_t = (bf16*)(ws + WS_WD);
    bf16* const XN = (bf16*)(ws + WS_XN); bf16* const PROJ = (bf16*)(ws + WS_PROJ); bf16* const MIX = (bf16*)(ws + WS_MIX); bf16* const HB = (bf16*)(ws + WS_H);

    for (int u = tid; u < (LDS_BYTES - LDSCTL_OFF) / 4; u += NWAVES * 64) ((LAS unsigned*)(L + LDSCTL_OFF))[u] = 0u;
    __syncthreads();
    XcdBarrier bar = xcd_barrier_post((unsigned*)(ctl + CW_BAR), MISC + 8);

    {
        LAS float* scr = (LAS float*)(L + RING_OFF + wave * 16384);
        constexpr int I_IN = (DM / 64) * (NIN / 32), I_OUT = (DM / 64) * (DM / 32), I_G = (DM / 64) * (DFF / 32), I_D = (DFF / 64) * (DM / 32);
        constexpr int NITEMS = I_IN + I_OUT + 2 * I_G + I_D;
        for (int it = gw; it < NITEMS; it += NGW) {
            int r = it;
            if (r < I_IN) { p0_transpose_item<0>(w_in, DM, NIN, norm1, Win_t, scr, r, lane); continue; } r -= I_IN;
            if (r < I_OUT) { p0_transpose_item<0>(w_out, DM, DM, nullptr, Wout_t, scr, r, lane); continue; } r -= I_OUT;
            if (r < I_G) { p0_transpose_item<1>(w_gate, DM, DFF, norm2, Wgu_t, scr, r, lane); continue; } r -= I_G;
            if (r < I_G) { p0_transpose_item<2>(w_up, DM, DFF, norm2, Wgu_t, scr, r, lane); continue; } r -= I_G;
            p0_transpose_item<0>(w_down, DFF, DM, nullptr, Wd_t, scr, r, lane);
        }
        for (int m = gw; m < MPAD; m += NGW) {
            GAS unsigned long long* o8 = (GAS unsigned long long*)(XN + (size_t)m * DM) + lane;
            if (m < MV) {
                const float* xrow = (m < MP) ? x_p + (size_t)m * DM : x_s + (size_t)(m - MP) * DM;
                const GAS f32x4* xr = (const GAS f32x4*)xrow + lane;
                f32x4 v[4]; float s = 0.f;
#pragma unroll
                for (int j = 0; j < 4; ++j) { v[j] = xr[64 * j]; s += (v[j].x * v[j].x + v[j].y * v[j].y) + (v[j].z * v[j].z + v[j].w * v[j].w); }
                const float rstd = 1.f / sqrtf(wave_sum(s) * (1.f / DM) + pg8::RMS_EPS);
                if (lane == 0) RSTD[m] = rstd;
#pragma unroll
                for (int j = 0; j < 4; ++j) o8[64 * j] = (unsigned long long)pk2(v[j].x, v[j].y) | ((unsigned long long)pk2(v[j].z, v[j].w) << 32);
            } else {
                if (lane == 0) RSTD[m] = 0.f;
#pragma unroll
                for (int j = 0; j < 4; ++j) o8[64 * j] = 0ull;
            }
        }
        {
            const int gt = gw * 64 + lane, NT = NGW * 64;
            const f32x4* ck4 = (const f32x4*)cache_k; const f32x4* cv4 = (const f32x4*)cache_v; const f32x4* sp4 = (const f32x4*)state_pool;
            f32x4* ok4 = (f32x4*)(out + pg8::OFF_KS); f32x4* ov4 = (f32x4*)(out + pg8::OFF_VS); f32x4* op4 = (f32x4*)(out + pg8::OFF_PS);
            for (int i = gt; i < 128 * 127 * 32; i += NT) { const int b = i / (127 * 32), r = i % (127 * 32); ok4[b * 4096 + r] = ck4[b * 4096 + 32 + r]; ov4[b * 4096 + r] = cv4[b * 4096 + 32 + r]; }
            for (int i = gt; i < 128 * 14 * 128; i += NT) { const int b = i / (14 * 128), r = i % (14 * 128); op4[b * 1920 + r] = sp4[b * 1920 + 128 + r]; }
        }
    }
    xcd_barrier(bar);

    {
        pg8::Gemm g{XN, Win_t, MPAD, NIN, DM}; pg8::StaticOrder S; S.init(MPAD, NIN, G, bx);
        pg8::EpiProj E{PROJ, RSTD, out};
        pg8::gemm_phase<pg8::EpiProj, pg8::StaticOrder, true, true>(L + RING_OFF, g, S, E);
    }
    xcd_barrier(bar);

    {
        for (int u = wave * G + vcu; u < 1280; u += NGW) {
            if (u < 1024) attn_unit<false>(PROJ, cache_k, cache_v, sinks, MIX, L + RING_OFF + wave * 20480, u >> 8, (u >> 7) & 1, u & 127, lane);
            else attn_unit<true>(PROJ, cache_k, cache_v, sinks, MIX, L + RING_OFF + wave * 20480, (u - 1024) & 127, (u - 1024) >> 7, 0, lane);
        }
        __syncthreads();
        LAS float* ms = (LAS float*)(L + RING_OFF + wave * 4096);
        for (int item = gw; item < (MV / 8) * 4; item += NGW) {
            const int rt = item >> 2, g = item & 3, w = 2 << g;
#pragma unroll
            for (int r = 0; r < 8; ++r) {
                const int row = rt * 8 + r;
#pragma unroll
                for (int hf = 0; hf < 2; ++hf) {
                    const int cc = lane + 64 * hf, c = g * 128 + cc;
                    const bf16* up = PROJ + (size_t)row * NIN + 768 + c;
                    const float self = bf1(*up); float sum = self, cnt;
                    if (row < MP) { const int t = row & 4095, n = (w - 1) < t ? (w - 1) : t; for (int k = 1; k <= n; ++k) sum += bf1(*(up - (size_t)k * NIN)); cnt = (float)(n + 1); }
                    else { const int b = row - MP; for (int j = 16 - w; j <= 14; ++j) sum += state_pool[(size_t)(b * 15 + j) * 512 + c]; cnt = (float)w; }
                    ms[cc * 8 + r] = sum / cnt - self;
                }
            }
            LDS_WAIT(); asm volatile("" ::: "memory");
            float a0[8], a1[8];
#pragma unroll
            for (int r = 0; r < 8; ++r) { a0[r] = 0.f; a1[r] = 0.f; }
            const float* wp = w_pool + (size_t)g * 128 * 128;
            for (int c = 0; c < 128; ++c) {
                const float w0 = wp[c * 128 + lane], w1 = wp[c * 128 + 64 + lane];
                const f32x4 ma = *(const LAS f32x4*)(ms + c * 8), mb = *(const LAS f32x4*)(ms + c * 8 + 4);
                a0[0] += ma.x * w0; a0[1] += ma.y * w0; a0[2] += ma.z * w0; a0[3] += ma.w * w0; a0[4] += mb.x * w0; a0[5] += mb.y * w0; a0[6] += mb.z * w0; a0[7] += mb.w * w0;
                a1[0] += ma.x * w1; a1[1] += ma.y * w1; a1[2] += ma.z * w1; a1[3] += ma.w * w1; a1[4] += mb.x * w1; a1[5] += mb.y * w1; a1[6] += mb.z * w1; a1[7] += mb.w * w1;
            }
            const float s0 = pool_scale[g * 128 + lane], s1 = pool_scale[g * 128 + 64 + lane];
#pragma unroll
            for (int r = 0; r < 8; ++r) { bf16* mp = MIX + (size_t)(rt * 8 + r) * DM + 512 + g * 128; mp[lane] = (bf16)f2bf(a0[r] * s0); mp[64 + lane] = (bf16)f2bf(a1[r] * s1); }
            LDS_WAIT(); asm volatile("" ::: "memory");
        }
    }
    xcd_barrier(bar);

    {
        pg8::Gemm g{MIX, Wout_t, MPAD, DM, DM}; pg8::StaticOrder S; S.init(MPAD, DM, G, bx);
        pg8::EpiRes<true> E{x_p, x_s, out, XN, SS2};
        pg8::gemm_phase<pg8::EpiRes<true>, pg8::StaticOrder, true, true>(L + RING_OFF, g, S, E);
    }
    xcd_barrier(bar);

    {
        pg8::Gemm g{XN, Wgu_t, MPAD, 2 * DFF, DM}; pg8::StaticOrder S; S.init(MPAD, 2 * DFF, G, bx);
        pg8::EpiSwiGLU E{HB, SS2};
        pg8::gemm_phase<pg8::EpiSwiGLU, pg8::StaticOrder, true, true>(L + RING_OFF, g, S, E);
    }
    xcd_barrier(bar);

    {
        pg8::Gemm g{HB, Wd_t, MPAD, DM, DFF}; pg8::StaticOrder S; S.init(MPAD, DM, G, bx);
        pg8::EpiRes<false> E{nullptr, nullptr, out, nullptr, SS3};
        pg8::gemm_phase<pg8::EpiRes<false>, pg8::StaticOrder, true, true>(L + RING_OFF, g, S, E);
    }
    xcd_barrier(bar);

    {
        const unsigned poison = xb_ld((unsigned*)(ctl + CW_BAR) + XB_TMO);
        for (int m = gw; m < MV; m += NGW) {
            const f32x4* sp = (const f32x4*)(SS3 + (size_t)m * 16);
            const f32x4 a = (sp[0] + sp[1]) + (sp[2] + sp[3]);
            float rs = 1.0f / sqrtf(((a[0] + a[1]) + (a[2] + a[3])) * (1.0f / DM) + pg8::RMS_EPS);
            if (poison) rs = __builtin_nanf("");
            GAS f32x4* xr = (GAS f32x4*)(out + (size_t)m * DM) + lane; const f32x4* gf = (const f32x4*)final_norm + lane;
#pragma unroll
            for (int j = 0; j < 4; ++j) { const f32x4 v = xr[64 * j]; xr[64 * j] = v * rs * gf[64 * j]; }
        }
    }
}

extern "C" void kernel_launch(void* const* d_in, const int* in_sizes, int n_in, void* d_out, int out_size, void* d_ws, size_t ws_size, hipStream_t stream) {
    static int grid = 0;
    if (grid == 0) {
        if (n_in != 16 || out_size != (int)pg8::OUT_TOTAL || ws_size < WS_END) { fprintf(stderr, "kernel_launch: unexpected shapes (n_in %d, out %d, ws %zu); nothing launched\n", n_in, out_size, ws_size); grid = -1; return; }
        int dev = 0, cus = 0, per_cu = 0;
        if (hipGetDevice(&dev) != hipSuccess || hipDeviceGetAttribute(&cus, hipDeviceAttributeMultiprocessorCount, dev) != hipSuccess) { grid = -1; return; }
        if (hipFuncSetAttribute((const void*)hymba_fwd, hipFuncAttributeMaxDynamicSharedMemorySize, LDS_BYTES) != hipSuccess) { fprintf(stderr, "kernel_launch: hipFuncSetAttribute failed\n"); grid = -1; return; }
        if (hipOccupancyMaxActiveBlocksPerMultiprocessor(&per_cu, (const void*)hymba_fwd, NWAVES * 64, LDS_BYTES) != hipSuccess || per_cu < 1)
            fprintf(stderr, "kernel_launch: note: occupancy query reports %d workgroups per CU\n", per_cu);
        (void)hipGetLastError();
        grid = cus;
    }
    if (grid < 0) return;
    if (hipMemsetAsync((char*)d_ws + WS_CTL, 0, CTL_ZERO_BYTES, stream) != hipSuccess) { fprintf(stderr, "kernel_launch: hipMemsetAsync failed\n"); return; }
    Args a{};
    for (int i = 0; i < 16; ++i) a.in[i] = (const float*)d_in[i];
    a.out = (float*)d_out; a.ws = (unsigned char*)d_ws;
    hipLaunchKernelGGL(hymba_fwd, dim3(grid), dim3(NWAVES * 64), LDS_BYTES, stream, a);
}
```

```cpp
#include <hip/hip_runtime.h>
#include <cstdio>
#include <cstdint>
namespace pg8 {
#define PG8_LAS __attribute__((address_space(3)))
typedef unsigned short bf16_t;
typedef short bf16x8 __attribute__((ext_vector_type(8)));
typedef float f32x4 __attribute__((ext_vector_type(4)));
typedef unsigned u32x4 __attribute__((ext_vector_type(4)));
constexpr int BM = 256, BK = 64, HALF = 128, HTB = HALF * BK * 2  , STAGE_BYTES = 8 * HTB, NXCD = 8, WGM = 8;

__host__ __device__ __forceinline__ int lds_byte(int r, int c) { const int st = (r >> 4) * 2 + (c >> 5), rr = r & 15, cc = c & 31, ob = rr * 64 + cc * 2; return st * 1024 + (ob ^ (((ob >> 9) & 1) << 5)); }
__host__ __device__ __forceinline__ void stage_rc(int b, int& R, int& C) { const int st = b / 1024, sb = b % 1024, swz = sb ^ (((sb >> 9) & 1) << 5); R = (st >> 1) * 16 + swz / 64; C = (st & 1) * 32 + (swz % 64) / 2; }
__host__ __device__ __forceinline__ int perm32(int rho) { const int n = rho >> 4, i = rho & 15; return 8 * (i >> 2) + 4 * n + (i & 3); }

struct Unit { int pm, pn; };
struct Gemm { const bf16_t* A; const bf16_t* Bt; int M, N, K; };

struct StaticOrder {
    int nM, nN, nwg, G, c;
    __host__ __device__ void init(int M, int N, int G_, int c_) { nM = M / BM; nN = N / BM; nwg = nM * nN; G = G_; c = c_; }
    __host__ __device__ bool next(int i, Unit& u) const {
        const long L = (long)i * G + c; if (L >= nwg) return false;
        int wgid = (int)L; { const int q = nwg / NXCD, r = nwg % NXCD, xcd = wgid % NXCD, off = wgid / NXCD; wgid = (xcd < r ? xcd * (q + 1) : r * (q + 1) + (xcd - r) * q) + off; }
        const int nig = WGM * nN, gid = wgid / nig, fm = gid * WGM, gsz = (nM - fm) < WGM ? (nM - fm) : WGM;
        u.pm = fm + ((wgid % nig) % gsz); u.pn = (wgid % nig) / gsz; return true;
    }
    __device__ __forceinline__ void a_ready(const Unit&) const {}
    __device__ __forceinline__ void done(const Unit&) const {}
};

__device__ __forceinline__ unsigned cvt_pk_bf16(float lo, float hi) { unsigned r; asm volatile("v_cvt_pk_bf16_f32 %0, %1, %2" : "=v"(r) : "v"(lo), "v"(hi)); return r; }
typedef float f32x2 __attribute__((ext_vector_type(2)));

typedef unsigned u32x2 __attribute__((ext_vector_type(2)));
constexpr int ROWS_P = 16384, ROWS_V = 16512;
constexpr size_t OFF_Y = 0, OFF_KP = 16908288, OFF_VP = 16973824, OFF_PP = 17039360, OFF_KS = 17070080, OFF_VS = 19167232, OFF_PS = 21264384, OUT_TOTAL = 22247424;
constexpr float RMS_EPS = 1e-5f;

__device__ __forceinline__ float* side_dst(float* out, int row, int col) {
    if (row < ROWS_P) { const int b = row >> 12, t = row & 4095;
        if (col < 768) { if (t < 3968) return nullptr; const bool isv = col >= 640; return out + (isv ? OFF_VP : OFF_KP) + (size_t)((b * 128 + (t - 3968)) * 128 + (col - (isv ? 640 : 512))); }
        if (t < 4081) return nullptr; return out + OFF_PP + (size_t)((b * 15 + (t - 4081)) * 512 + (col - 768)); }
    if (row < ROWS_V) { const int b = row - ROWS_P;
        if (col < 768) { const bool isv = col >= 640; return out + (isv ? OFF_VS : OFF_KS) + (size_t)((b * 128 + 127) * 128 + (col - (isv ? 640 : 512))); }
        return out + OFF_PS + (size_t)((b * 15 + 14) * 512 + (col - 768)); }
    return nullptr;
}
struct EpiProj {
    static constexpr bool PERM = true, AFTER_DRAIN = false;
    bf16_t* P; const float* rstd; float* out;
    __device__ __forceinline__ void operator()(const f32x4 (&acc)[2][2][4][2], const Unit& u, int wr, int wc, int fr, int fq) const {
        const int col0 = u.pn * BM + wc * 32 + 8 * fq;
        const bool side = (u.pn >= 2) && (u.pm == 64 || (u.pm & 15) == 15);
#pragma unroll
        for (int ai = 0; ai < 2; ++ai)
#pragma unroll
            for (int m = 0; m < 4; ++m) {
                const int row = u.pm * BM + ai * HALF + wr * 64 + m * 16 + fr;
                const float rs = rstd[row];
                bf16_t* rowp = P + (size_t)row * 1280 + col0;
#pragma unroll
                for (int bj = 0; bj < 2; ++bj) {
                    const f32x4 v0 = acc[ai][bj][m][0] * rs, v1 = acc[ai][bj][m][1] * rs;
                    u32x4 w; w.x = cvt_pk_bf16(v0[0], v0[1]); w.y = cvt_pk_bf16(v0[2], v0[3]); w.z = cvt_pk_bf16(v1[0], v1[1]); w.w = cvt_pk_bf16(v1[2], v1[3]);
                    *(u32x4*)(rowp + bj * HALF) = w;
                    if (side) { float* d = side_dst(out, row, col0 + bj * HALF); if (d) { *(f32x4*)d = v0; *(f32x4*)(d + 4) = v1; } }
                }
            }
    }
};
template <bool FIRST> struct EpiRes {
    static constexpr bool PERM = false, AFTER_DRAIN = false;
    const float* xp; const float* xs; float* out; bf16_t* XN; float* SS;
    __device__ __forceinline__ void operator()(const f32x4 (&acc)[2][2][4][2], const Unit& u, int wr, int wc, int fr, int fq) const {
        const int col0 = u.pn * BM + wc * 32 + 4 * fq;
#pragma unroll
        for (int ai = 0; ai < 2; ++ai)
#pragma unroll
            for (int m = 0; m < 4; ++m) {
                const int row = u.pm * BM + ai * HALF + wr * 64 + m * 16 + fr;
                if (row < ROWS_V) {
                    float* orow = out + (size_t)row * 1024 + col0;
                    const float* xr = FIRST ? ((row < ROWS_P) ? xp + (size_t)row * 1024 : xs + (size_t)(row - ROWS_P) * 1024) + col0 : orow;
                    float ss = 0.f;
#pragma unroll
                    for (int bj = 0; bj < 2; ++bj)
#pragma unroll
                        for (int n = 0; n < 2; ++n) {
                            const int c = bj * HALF + n * 16;
                            const f32x4 v = *(const f32x4*)(xr + c) + acc[ai][bj][m][n];
                            *(f32x4*)(orow + c) = v;
                            if (FIRST) { u32x2 w; w.x = cvt_pk_bf16(v[0], v[1]); w.y = cvt_pk_bf16(v[2], v[3]); *(u32x2*)(XN + (size_t)row * 1024 + col0 + c) = w; }
                            ss += (v[0] * v[0] + v[1] * v[1]) + (v[2] * v[2] + v[3] * v[3]);
                        }
                    ss += __shfl_xor(ss, 16); ss += __shfl_xor(ss, 32);
                    if (fq == 0) SS[(size_t)row * 16 + u.pn * 4 + wc] = ss;
                }
            }
    }
};
struct EpiSwiGLU {
    static constexpr bool PERM = true, AFTER_DRAIN = false;
    bf16_t* H; const float* SS;
    __device__ __forceinline__ void operator()(const f32x4 (&acc)[2][2][4][2], const Unit& u, int wr, int wc, int fr, int fq) const {
        const int colh = u.pn * HALF + wc * 32 + 8 * fq;
#pragma unroll
        for (int ai = 0; ai < 2; ++ai)
#pragma unroll
            for (int m = 0; m < 4; ++m) {
                const int row = u.pm * BM + ai * HALF + wr * 64 + m * 16 + fr;
                const f32x4* sp = (const f32x4*)(SS + (size_t)row * 16);
                const f32x4 a = (sp[0] + sp[1]) + (sp[2] + sp[3]);
                const float rs = 1.0f / sqrtf(((a[0] + a[1]) + (a[2] + a[3])) * (1.0f / 1024.0f) + RMS_EPS);
                float hv[8];
#pragma unroll
                for (int n = 0; n < 2; ++n)
#pragma unroll
                    for (int j = 0; j < 4; ++j) {
                        const float g = acc[ai][0][m][n][j] * rs, uu = acc[ai][1][m][n][j] * rs;
                        const float sg = g * __builtin_amdgcn_rcpf(1.0f + __builtin_amdgcn_exp2f(-1.4426950408889634f * g));
                        hv[n * 4 + j] = sg * uu;
                    }
                u32x4 w; w.x = cvt_pk_bf16(hv[0], hv[1]); w.y = cvt_pk_bf16(hv[2], hv[3]); w.z = cvt_pk_bf16(hv[4], hv[5]); w.w = cvt_pk_bf16(hv[6], hv[7]);
                *(u32x4*)(H + (size_t)row * 2816 + colh) = w;
            }
    }
};

template <class Epi, class Sched, bool ALIGN_EPI = false, bool SP2 = false>
__device__ __forceinline__ void gemm_phase(PG8_LAS unsigned char* lds, const Gemm g, const Sched& S, const Epi& E) {
    int tid_ = threadIdx.x; asm volatile("" : "+v"(tid_));
    const int tid = tid_, wid = __builtin_amdgcn_readfirstlane(tid >> 6), lane = tid & 63, wr = wid >> 2, wc = wid & 3, fr = lane & 15, fq = lane >> 4;
    const int K = g.K, nt = K / BK;
    unsigned voffA[2], voffB[2];
#pragma unroll
    for (int i = 0; i < 2; ++i) { int R, C; stage_rc(tid * 16 + i * 8192, R, C); const int Rb = Epi::PERM ? ((R & ~31) + perm32(R & 31)) : R;
        voffA[i] = (unsigned)(R * K + C) * 2u; voffB[i] = (unsigned)(Rb * K + C) * 2u; }
    const size_t kstep = (size_t)(BK * 2);
    const size_t hstep = (size_t)HALF * K * 2;
    const size_t tstep = 2 * hstep;
    const unsigned ldsw = (unsigned)wid * 1024u;
    const int aoff = lds_byte(wr * 64 + fr, fq * 8), boff = lds_byte(wc * 32 + fr, fq * 8);
#define PG8_SA(b, h) (((b) * 2 + (h)) * HTB)
#define PG8_SB(b, h) ((4 + (b) * 2 + (h)) * HTB)
#define PG8_STAGE(bufoff, gbase, voff) do { _Pragma("unroll") for (int _i = 0; _i < 2; ++_i) \
        __builtin_amdgcn_global_load_lds((const unsigned*)((const char*)(gbase) + (voff)[_i]), (PG8_LAS unsigned*)(lds + (bufoff) + ldsw + _i * 8192), 16, 0, 0); } while (0)
#define PG8_LDA(dst, b, h) do { _Pragma("unroll") for (int m = 0; m < 4; ++m) _Pragma("unroll") for (int k = 0; k < 2; ++k) dst[m][k] = *(const PG8_LAS bf16x8*)(lds + PG8_SA(b, h) + aoff + m * 2048 + k * 1024); } while (0)
#define PG8_LDB(dst, b, h) do { _Pragma("unroll") for (int n = 0; n < 2; ++n) _Pragma("unroll") for (int k = 0; k < 2; ++k) dst[n][k] = *(const PG8_LAS bf16x8*)(lds + PG8_SB(b, h) + boff + n * 2048 + k * 1024); } while (0)
#define PG8_MMA(ai, bj, At, Bt) do { __builtin_amdgcn_s_setprio(1); _Pragma("unroll") for (int m = 0; m < 4; ++m) _Pragma("unroll") for (int n = 0; n < 2; ++n) _Pragma("unroll") for (int k = 0; k < 2; ++k) \
        acc[ai][bj][m][n] = __builtin_amdgcn_mfma_f32_16x16x32_bf16(Bt[n][k], At[m][k], acc[ai][bj][m][n], 0, 0, 0); __builtin_amdgcn_s_setprio(0); } while (0)
#define PG8_WAIT_V(n) asm volatile("s_waitcnt vmcnt(" #n ")" ::: "memory")
#define PG8_WAIT_L(n) asm volatile("s_waitcnt lgkmcnt(" #n ")" ::: "memory")
#define PG8_BAR __builtin_amdgcn_s_barrier()
#define PG8_SCHED __builtin_amdgcn_sched_barrier(0)
    Unit cur, nxt; int ui = 0;
    if (!S.next(0, cur)) return;
    f32x4 acc[2][2][4][2];
#pragma unroll
    for (int a = 0; a < 2; ++a)
#pragma unroll
        for (int b = 0; b < 2; ++b)
#pragma unroll
            for (int m = 0; m < 4; ++m)
#pragma unroll
                for (int n = 0; n < 2; ++n) acc[a][b][m][n] = (f32x4){0.f, 0.f, 0.f, 0.f};
    bf16x8 At[4][2], B0[2][2], B1[2][2];
    const char* cA = (const char*)g.A + (size_t)cur.pm * tstep; const char* cB = (const char*)g.Bt + (size_t)cur.pn * tstep;
    S.a_ready(cur);
    if constexpr (SP2) {
        PG8_STAGE(PG8_SB(0, 0), cB, voffB); PG8_STAGE(PG8_SB(0, 1), cB + hstep, voffB); PG8_STAGE(PG8_SA(0, 0), cA, voffA); PG8_STAGE(PG8_SA(0, 1), cA + hstep, voffA);
        if (wr == 1) PG8_BAR;
        PG8_WAIT_V(2); PG8_BAR;
        PG8_STAGE(PG8_SB(1, 0), cB + kstep, voffB); PG8_STAGE(PG8_SA(1, 0), cA + kstep, voffA); PG8_STAGE(PG8_SB(1, 1), cB + hstep + kstep, voffB);
        PG8_WAIT_V(6); PG8_BAR;
    } else {
        PG8_STAGE(PG8_SB(0, 0), cB, voffB); PG8_STAGE(PG8_SA(0, 0), cA, voffA); PG8_STAGE(PG8_SB(0, 1), cB + hstep, voffB); PG8_STAGE(PG8_SA(0, 1), cA + hstep, voffA);
        if (wr == 1) PG8_BAR;
        PG8_WAIT_V(4); PG8_BAR;
        PG8_STAGE(PG8_SB(1, 0), cB + kstep, voffB); PG8_STAGE(PG8_SA(1, 0), cA + kstep, voffA); PG8_STAGE(PG8_SB(1, 1), cB + hstep + kstep, voffB);
        PG8_WAIT_V(6); PG8_BAR;
    }
    for (;;) {
        const bool has_next = S.next(ui + 1, nxt);
        const char* nA = has_next ? (const char*)g.A + (size_t)nxt.pm * tstep : cA; const char* nB = has_next ? (const char*)g.Bt + (size_t)nxt.pn * tstep : cB;
        for (int t = 0; t < nt; t += 2) {
            const bool last = (t == nt - 2);
            const char* a1 = cA + (size_t)(t + 1) * kstep;
            const char* a2 = last ? nA : cA + (size_t)(t + 2) * kstep; const char* b2 = last ? nB : cB + (size_t)(t + 2) * kstep;
            const char* a3 = a2 + kstep; const char* b3 = b2 + kstep;
            if (last && has_next) S.a_ready(nxt);
            if constexpr (SP2) {
            PG8_LDB(B0, 0, 0); PG8_LDB(B1, 0, 1); PG8_SCHED; PG8_LDA(At, 0, 0); PG8_STAGE(PG8_SA(1, 1), a1 + hstep, voffA);
            PG8_WAIT_V(8); PG8_WAIT_L(0); PG8_BAR; PG8_MMA(0, 0, At, B0); PG8_MMA(0, 1, At, B1); PG8_BAR; PG8_SCHED;
            PG8_LDA(At, 0, 1); PG8_STAGE(PG8_SB(0, 0), b2, voffB); PG8_STAGE(PG8_SB(0, 1), b2 + hstep, voffB); PG8_STAGE(PG8_SA(0, 0), a2, voffA);
            PG8_WAIT_V(8); PG8_WAIT_L(0); PG8_BAR; PG8_MMA(1, 0, At, B0); PG8_MMA(1, 1, At, B1); PG8_BAR; PG8_SCHED;
            PG8_LDB(B0, 1, 0); PG8_LDB(B1, 1, 1); PG8_SCHED; PG8_LDA(At, 1, 0); PG8_STAGE(PG8_SA(0, 1), a2 + hstep, voffA);
            PG8_WAIT_V(8); PG8_WAIT_L(0); PG8_BAR; PG8_MMA(0, 0, At, B0); PG8_MMA(0, 1, At, B1); PG8_BAR; PG8_SCHED;
            PG8_LDA(At, 1, 1); PG8_STAGE(PG8_SB(1, 0), b3, voffB); PG8_STAGE(PG8_SB(1, 1), b3 + hstep, voffB); PG8_STAGE(PG8_SA(1, 0), a3, voffA);
            PG8_WAIT_V(8); PG8_WAIT_L(0); PG8_BAR; PG8_MMA(1, 0, At, B0); PG8_MMA(1, 1, At, B1); PG8_BAR; PG8_SCHED;
            } else {
            PG8_LDB(B0, 0, 0); PG8_SCHED; PG8_LDA(At, 0, 0); PG8_STAGE(PG8_SA(1, 1), a1 + hstep, voffA);
            PG8_WAIT_L(8); PG8_BAR; PG8_WAIT_L(0); PG8_MMA(0, 0, At, B0); PG8_BAR; PG8_SCHED;
            PG8_LDB(B1, 0, 1); PG8_STAGE(PG8_SB(0, 0), b2, voffB);
            PG8_BAR; PG8_WAIT_L(0); PG8_MMA(0, 1, At, B1); PG8_BAR;
            PG8_LDA(At, 0, 1); PG8_STAGE(PG8_SA(0, 0), a2, voffA);
            PG8_BAR; PG8_WAIT_L(0); PG8_MMA(1, 0, At, B0); PG8_BAR; PG8_SCHED;
            PG8_STAGE(PG8_SB(0, 1), b2 + hstep, voffB);
            PG8_WAIT_V(6); PG8_BAR; PG8_MMA(1, 1, At, B1); PG8_BAR;
            PG8_LDB(B0, 1, 0); PG8_SCHED; PG8_LDA(At, 1, 0); PG8_STAGE(PG8_SA(0, 1), a2 + hstep, voffA);
            PG8_WAIT_L(8); PG8_BAR; PG8_WAIT_L(0); PG8_MMA(0, 0, At, B0); PG8_BAR; PG8_SCHED;
            PG8_LDB(B1, 1, 1); PG8_STAGE(PG8_SB(1, 0), b3, voffB);
            PG8_BAR; PG8_WAIT_L(0); PG8_MMA(0, 1, At, B1); PG8_BAR;
            PG8_LDA(At, 1, 1); PG8_STAGE(PG8_SA(1, 0), a3, voffA);
            PG8_BAR; PG8_WAIT_L(0); PG8_MMA(1, 0, At, B0); PG8_BAR; PG8_SCHED;
            PG8_STAGE(PG8_SB(1, 1), b3 + hstep, voffB);
            PG8_WAIT_V(6); PG8_BAR; PG8_MMA(1, 1, At, B1); PG8_BAR;
            }
        }
        if constexpr (ALIGN_EPI) { if (wr == 0) PG8_BAR; }
        if constexpr (!Epi::AFTER_DRAIN) { E(acc, cur, wr, wc, fr, fq); S.done(cur); }
        if (!has_next) break;
#pragma unroll
        for (int a = 0; a < 2; ++a)
#pragma unroll
            for (int b = 0; b < 2; ++b)
#pragma unroll
                for (int m = 0; m < 4; ++m)
#pragma unroll
                    for (int n = 0; n < 2; ++n) acc[a][b][m][n] = (f32x4){0.f, 0.f, 0.f, 0.f};
        cur = nxt; cA = nA; cB = nB; ++ui;
        if constexpr (ALIGN_EPI) { if (wr == 1) PG8_BAR; }
    }
    PG8_WAIT_V(0);
    if constexpr (!ALIGN_EPI) { if (wr == 0) PG8_BAR; }
    PG8_BAR;
    if constexpr (Epi::AFTER_DRAIN) { E.fused(acc, cur, wr, wc, fr, fq, lds, wid, lane); S.done(cur); }
#undef PG8_SA
#undef PG8_SB
#undef PG8_STAGE
#undef PG8_LDA
#undef PG8_LDB
#undef PG8_MMA
#undef PG8_WAIT_V
#undef PG8_WAIT_L
#undef PG8_BAR
#undef PG8_SCHED
}
}
#define GAS __attribute__((address_space(1)))
#define LAS __attribute__((address_space(3)))
typedef unsigned short bf16;
typedef unsigned v4u __attribute__((ext_vector_type(4)));
typedef float f32x4 __attribute__((ext_vector_type(4)));
typedef short bf16x8 __attribute__((ext_vector_type(8)));
typedef GAS unsigned gu32;
typedef GAS unsigned long long gu64;
#define RLX_AGENT __ATOMIC_RELAXED, __HIP_MEMORY_SCOPE_AGENT
#define LDS_WAIT() asm volatile("s_waitcnt lgkmcnt(0)" ::: "memory")
#define VM_WAIT() asm volatile("s_waitcnt vmcnt(0)" ::: "memory")
__device__ __forceinline__ unsigned long long rt() { return __builtin_amdgcn_s_memrealtime(); }
__device__ __forceinline__ unsigned f2bf(float f) { unsigned u = __builtin_bit_cast(unsigned, f); return (u + 0x7fffu + ((u >> 16) & 1u)) >> 16; }
__device__ __forceinline__ unsigned pk2(float lo, float hi) { return f2bf(lo) | (f2bf(hi) << 16); }

#define XB_TMO      128
#define XB_XCNT(j)  (256  + 64 * (j))
#define XB_XSUB(j)  (1280 + 64 * (j))
#define XB_XGEN(j)  (2304 + 64 * (j))
#define XB_TOP      3328
#define XB_TOPGEN   3392
#define XCD_BAR_WORDS 3456
#define XB_SPIN_CAP (1u << 18)

__device__ __forceinline__ unsigned xb_ld(unsigned* p)              { return __hip_atomic_load(p, __ATOMIC_RELAXED, __HIP_MEMORY_SCOPE_AGENT); }
__device__ __forceinline__ unsigned xb_add(unsigned* p, unsigned v) { return __hip_atomic_fetch_add(p, v, __ATOMIC_RELAXED, __HIP_MEMORY_SCOPE_AGENT); }
__device__ __forceinline__ unsigned xb_xcc_id() { return (unsigned)__builtin_amdgcn_s_getreg((3 << 11) | 20) & 0xFu; }
#define XB_SPIN(cond, bar) do { unsigned _sp = 0; while (cond) { __builtin_amdgcn_s_sleep(1); \
    if ((++_sp & 255u) == 0u) { if (xb_ld(&(bar)[XB_TMO])) break; if (_sp > XB_SPIN_CAP) { atomicAdd(&(bar)[XB_TMO], 1u); break; } } } } while (0)

struct XcdBarrier {
    unsigned* bar; unsigned x;
    volatile LAS unsigned* st;
};

__device__ __forceinline__ XcdBarrier xcd_barrier_post(unsigned* bar, volatile LAS unsigned* st) {
    XcdBarrier b; b.bar = bar; b.x = xb_xcc_id(); b.st = st;
    if (threadIdx.x == 0) (void)xb_add(&bar[XB_XCNT(b.x)], 1u);
    return b;
}
__device__ __forceinline__ void xcd_barrier_complete(unsigned* bar, unsigned x, unsigned& nloc, unsigned& nx) {
    const unsigned G = gridDim.x * gridDim.y * gridDim.z;
    unsigned sum, cnt, mine, sp = 0u;
    for (;;) {
        sum = 0u; cnt = 0u; mine = 0u;
#pragma unroll
        for (unsigned j = 0; j < 16; ++j) { const unsigned c = xb_ld(&bar[XB_XCNT(j)]); sum += c; cnt += (c > 0u) ? 1u : 0u; mine = (j == x) ? c : mine; }
        if (sum == G) break;
        __builtin_amdgcn_s_sleep(1);
        if ((++sp & 255u) == 0u) { if (xb_ld(&bar[XB_TMO])) break; if (sp > XB_SPIN_CAP) { atomicAdd(&bar[XB_TMO], 1u); break; } }
    }
    nloc = mine > 0u ? mine : 1u; nx = cnt > 0u ? cnt : 1u;
}

__device__ __forceinline__ void xcd_barrier(const XcdBarrier& b) {
    asm volatile("s_waitcnt vmcnt(0)" ::: "memory");
    __syncthreads();
    if (threadIdx.x == 0) {
        unsigned* bar = b.bar;
        __builtin_amdgcn_s_waitcnt(0);
        unsigned nloc = b.st[0], nx = b.st[1];
        if (nloc == 0u) { xcd_barrier_complete(bar, b.x, nloc, nx); b.st[0] = nloc; b.st[1] = nx; }
        const unsigned old = xb_add(&bar[XB_XSUB(b.x)], 1u);
        const unsigned gen = old / nloc;
        if (old + 1u == (gen + 1u) * nloc) {
            __builtin_amdgcn_fence(__ATOMIC_RELEASE, "agent");
            asm volatile("s_waitcnt vmcnt(0)" ::: "memory");
            const unsigned og = xb_add(&bar[XB_TOP], 1u);
            const unsigned tg = og / nx;
            if (og + 1u == (tg + 1u) * nx) xb_add(&bar[XB_TOPGEN], 1u);
            else XB_SPIN(xb_ld(&bar[XB_TOPGEN]) == tg, bar);
            __builtin_amdgcn_fence(__ATOMIC_ACQUIRE, "agent");
            xb_add(&bar[XB_XGEN(b.x)], 1u);
            asm volatile("s_waitcnt vmcnt(0)" ::: "memory");
        } else {
            XB_SPIN(xb_ld(&bar[XB_XGEN(b.x)]) == gen, bar);
            __builtin_amdgcn_fence(__ATOMIC_ACQUIRE, "agent");
            asm volatile("s_waitcnt vmcnt(0)" ::: "memory");
        }
    }
    __syncthreads();
}

constexpr int NWAVES = 8;
constexpr int DM = 1024, MP = 16384, MSMP = 128, MV = 16512, MPAD = 16640, NIN = 1280, DFF = 2816;
constexpr size_t MiB = 1u << 20;
constexpr size_t WS_CTL = 0, CTL_ZERO_BYTES = 65536;
constexpr size_t WS_RSTD = 1 * MiB;
constexpr size_t WS_SS2 = 2 * MiB, WS_SS3 = 4 * MiB;
constexpr size_t WS_WIN = 6 * MiB, WS_WOUT = 9 * MiB, WS_WGU = 11 * MiB, WS_WD = 22 * MiB;
constexpr size_t WS_XN = 28 * MiB;
constexpr size_t WS_PROJ = 61 * MiB;
constexpr size_t WS_MIX = 102 * MiB;
constexpr size_t WS_H = 135 * MiB;
constexpr size_t WS_END = 225 * MiB;
static_assert(WS_WIN + (size_t)NIN * DM * 2 <= WS_WOUT && WS_WGU + (size_t)2 * DFF * DM * 2 <= WS_WD && WS_WD + (size_t)DM * DFF * 2 <= WS_XN, "ws map: weights");
static_assert(WS_XN + (size_t)MPAD * DM * 2 <= WS_PROJ && WS_PROJ + (size_t)MPAD * NIN * 2 <= WS_MIX && WS_MIX + (size_t)MPAD * DM * 2 <= WS_H && WS_H + (size_t)MPAD * DFF * 2 <= WS_END, "ws map: activations");
static_assert(WS_SS2 + (size_t)MPAD * 64 <= WS_SS3 && WS_SS3 + (size_t)MPAD * 64 <= WS_WIN, "ws map: stats");
constexpr int CW_BAR = 4096;
static_assert((CW_BAR + XCD_BAR_WORDS) * 4 <= (int)CTL_ZERO_BYTES, "barrier words inside the memset region");
constexpr int RING_OFF = 0, RING_BYTES = 131072, LDSCTL_OFF = RING_BYTES, MISC_OFF = LDSCTL_OFF + 320, LDS_BYTES = 147456;

__device__ __forceinline__ float wave_sum(float v) {
#pragma unroll
    for (int o = 1; o < 64; o <<= 1) v += __shfl_xor(v, o);
    return v;
}
__device__ __forceinline__ float bflo(unsigned w) { return __builtin_bit_cast(float, w << 16); }
__device__ __forceinline__ float bfhi(unsigned w) { return __builtin_bit_cast(float, w & 0xffff0000u); }
__device__ __forceinline__ float bf1(bf16 b) { return __builtin_bit_cast(float, (unsigned)b << 16); }

template <int MODE>
__device__ __forceinline__ void p0_transpose_item(const float* W, int K, int N, const float* gain, bf16* WT, LAS float* scr, int item, int lane) {
    const int nblk = N / 32, kb = item / nblk, nb = item % nblk, k0 = 64 * kb, n0 = 32 * nb;
#pragma unroll 8
    for (int i = 0; i < 32; ++i) { const int kk = 2 * i + (lane >> 5); float w = W[(size_t)(k0 + kk) * N + n0 + (lane & 31)]; if (gain) w *= gain[k0 + kk]; scr[kk * 33 + (lane & 31)] = w; }
    LDS_WAIT(); asm volatile("" ::: "memory");
    const int c = lane & 7;
#pragma unroll
    for (int j = 0; j < 4; ++j) { const int n = (lane >> 3) + 8 * j; const LAS float* s = scr + (8 * c) * 33 + n;
        v4u o; o.x = pk2(s[0 * 33], s[1 * 33]); o.y = pk2(s[2 * 33], s[3 * 33]); o.z = pk2(s[4 * 33], s[5 * 33]); o.w = pk2(s[6 * 33], s[7 * 33]);
        const int nn = n0 + n, orow = (MODE == 0) ? nn : ((nn >> 7) * 256 + (MODE == 2 ? 128 : 0) + (nn & 127));
        *(GAS v4u*)(WT + (size_t)orow * K + k0 + 8 * c) = o; }
    LDS_WAIT(); asm volatile("" ::: "memory");
}


typedef float f32x16 __attribute__((ext_vector_type(16)));
typedef unsigned short u16x8 __attribute__((ext_vector_type(8)));
__device__ __forceinline__ unsigned cvtpk(float lo, float hi) { typedef float f2_t __attribute__((ext_vector_type(2))); typedef __bf16 b2_t __attribute__((ext_vector_type(2)));
    f2_t v = {lo, hi}; b2_t b = __builtin_convertvector(v, b2_t); return __builtin_bit_cast(unsigned, b); }
__device__ __forceinline__ bf16x8 pack8(float a0, float a1, float a2, float a3, float a4, float a5, float a6, float a7) {
    v4u w; w.x = cvtpk(a0, a1); w.y = cvtpk(a2, a3); w.z = cvtpk(a4, a5); w.w = cvtpk(a6, a7); return __builtin_bit_cast(bf16x8, w); }
constexpr float LOG2E = 1.4426950408889634f;

template <bool SAMPLE>
__device__ __forceinline__ void attn_unit(const bf16* PROJ, const float* cache_k, const float* cache_v, const float* sinks, bf16* MIX, LAS unsigned char* vst, int b, int kvh, int qb, int lane) {
    const int r = lane & 31, hh = lane >> 5;
    const int nskip = SAMPLE ? 0 : (qb < 4 ? 4 - qb : 0);
    const size_t R0 = SAMPLE ? 0 : (size_t)b * 4096; const int q0 = qb * 32;
    const size_t srow = (size_t)MP + b;
    const bf16x8 zero8 = {0, 0, 0, 0, 0, 0, 0, 0};
#pragma unroll 2
    for (int it = 0; it < 20; ++it) {
        const int rr = 8 * it + (lane >> 3), c = lane & 7;
        v4u w = {0u, 0u, 0u, 0u};
        if (!SAMPLE) { if (it >= 4 * nskip) w = *(const v4u*)(PROJ + (R0 + q0 - 128 + rr) * NIN + 640 + kvh * 64 + 8 * c); }
        else if (it < 16) { const f32x4* vp = (const f32x4*)(cache_v + ((size_t)(b * 128 + rr) * 2 + kvh) * 64 + 8 * c); const f32x4 a = vp[0], d = vp[1];
            w.x = cvtpk(a[0], a[1]); w.y = cvtpk(a[2], a[3]); w.z = cvtpk(d[0], d[1]); w.w = cvtpk(d[2], d[3]); }
        else if (it == 16) { const v4u vn = *(const v4u*)(PROJ + srow * NIN + 640 + kvh * 64 + 8 * c); if (rr == 128) w = vn; }
        *(LAS v4u*)(vst + rr * 128 + c * 16) = w;
    }
    const LAS unsigned short* vrd = (const LAS unsigned short*)(vst + (4 * hh) * 128 + r * 2);
    constexpr int NG = SAMPLE ? 1 : 4;
#pragma unroll 1
    for (int g = 0; g < NG; ++g) {
        const int head = kvh * 4 + (SAMPLE ? (r & 3) : g);
        const bool colok = !SAMPLE || r < 4;
        bf16x8 qf[4];
        { const bf16* qp = PROJ + (SAMPLE ? srow : R0 + q0 + r) * NIN + head * 64 + 8 * hh;
#pragma unroll
          for (int ds = 0; ds < 4; ++ds) qf[ds] = colok ? *(const bf16x8*)(qp + 16 * ds) : zero8; }
        const float slope2 = __builtin_amdgcn_exp2f(-(float)(head + 1)) * LOG2E, sink2 = sinks[head] * LOG2E;
        float mx = sink2, lh = 0.f;
        f32x16 O[2];
#pragma unroll
        for (int k = 0; k < 16; ++k) { O[0][k] = 0.f; O[1][k] = 0.f; }
        const int rb = SAMPLE ? -4 * hh : r - 4 * hh;
#pragma unroll 1
        for (int i = nskip; i < 5; ++i) {
            f32x16 S;
#pragma unroll
            for (int k = 0; k < 16; ++k) S[k] = 0.f;
            if (!SAMPLE || i < 4) {
                const bf16* kpb = PROJ + (R0 + q0 - 128 + 32 * i + r) * NIN + 512 + kvh * 64 + 8 * hh;
                const float* kpf = cache_k + ((size_t)(b * 128 + 32 * i + r) * 2 + kvh) * 64 + 8 * hh;
#pragma unroll
                for (int ds = 0; ds < 4; ++ds) {
                    bf16x8 kf;
                    if (!SAMPLE) kf = *(const bf16x8*)(kpb + 16 * ds);
                    else { const f32x4 a = *(const f32x4*)(kpf + 16 * ds), c = *(const f32x4*)(kpf + 16 * ds + 4); kf = pack8(a[0], a[1], a[2], a[3], c[0], c[1], c[2], c[3]); }
                    S = __builtin_amdgcn_mfma_f32_32x32x16_bf16(kf, qf[ds], S, 0, 0, 0);
                }
            } else {
#pragma unroll
                for (int ds = 0; ds < 4; ++ds) {
                    const bf16x8 kn = *(const bf16x8*)(PROJ + srow * NIN + 512 + kvh * 64 + 16 * ds + 8 * hh); const bf16x8 kf = (r == 0) ? kn : zero8;
                    S = __builtin_amdgcn_mfma_f32_32x32x16_bf16(kf, qf[ds], S, 0, 0, 0);
                }
            }
            const int relb = 128 - 32 * i + rb;
            float tm = -1e30f;
#pragma unroll
            for (int k = 0; k < 16; ++k) {
                const int rel = relb - ((k & 3) + 8 * (k >> 2));
                const bool valid = SAMPLE ? (rel >= 0) : ((unsigned)rel <= 128u);
                const float sc = valid ? S[k] * (0.125f * LOG2E) - slope2 * (float)rel : -1e30f;
                S[k] = sc; tm = fmaxf(tm, sc);
            }
            tm = fmaxf(tm, __shfl_xor(tm, 32));
            const float mn = fmaxf(mx, tm), alpha = __builtin_amdgcn_exp2f(mx - mn); mx = mn;
            float ps = 0.f;
#pragma unroll
            for (int k = 0; k < 16; ++k) { const float p = __builtin_amdgcn_exp2f(S[k] - mn); S[k] = p; ps += p; }
            lh = lh * alpha + ps;
#pragma unroll
            for (int k = 0; k < 16; ++k) { O[0][k] *= alpha; O[1][k] *= alpha; }
            const LAS unsigned short* vt = vrd + i * 2048;
#pragma unroll
            for (int s = 0; s < 2; ++s) {
                const bf16x8 pf = pack8(S[8 * s + 0], S[8 * s + 1], S[8 * s + 2], S[8 * s + 3], S[8 * s + 4], S[8 * s + 5], S[8 * s + 6], S[8 * s + 7]);
#pragma unroll
                for (int db = 0; db < 2; ++db) {
                    u16x8 e;
#pragma unroll
                    for (int j = 0; j < 8; ++j) e[j] = vt[(16 * s + 8 * (j >> 2) + (j & 3)) * 64 + 32 * db];
                    O[db] = __builtin_amdgcn_mfma_f32_32x32x16_bf16(__builtin_bit_cast(bf16x8, e), pf, O[db], 0, 0, 0);
                }
            }
        }
        const float l = lh + __shfl_xor(lh, 32) + __builtin_amdgcn_exp2f(sink2 - mx);
        const float il = 1.0f / l;
        if (colok) {
            bf16* op = MIX + (SAMPLE ? srow : R0 + q0 + r) * DM + head * 64 + 4 * hh;
#pragma unroll
            for (int db = 0; db < 2; ++db)
#pragma unroll
                for (int k4 = 0; k4 < 4; ++k4) { pg8::u32x2 w; w.x = cvtpk(O[db][4 * k4] * il, O[db][4 * k4 + 1] * il); w.y = cvtpk(O[db][4 * k4 + 2] * il, O[db][4 * k4 + 3] * il);
                    *(pg8::u32x2*)(op + 32 * db + 8 * k4) = w; }
        }
    }
}

template <int NCH, class Epi>
__device__ __forceinline__ void small_tile(const bf16* X, int ldx, int m0, const bf16* Wt, int K, int nA, int nB, LAS float* red, int wave, int lane, const Epi& E) {
    const int r = lane & 31, hh = lane >> 5, ksl = K >> 3;
    f32x16 acc[NCH];
#pragma unroll
    for (int c = 0; c < NCH; ++c)
#pragma unroll
        for (int k = 0; k < 16; ++k) acc[c][k] = 0.f;
    const bf16* xp = X + (size_t)(m0 + r) * ldx + wave * ksl + 8 * hh;
    const bf16* wa = Wt + (size_t)(nA + r) * K + wave * ksl + 8 * hh;
    const bf16* wb = Wt + (size_t)(nB + r) * K + wave * ksl + 8 * hh;
#pragma unroll 4
    for (int ks = 0; ks < (ksl >> 4); ++ks) {
        const bf16x8 xb = *(const bf16x8*)(xp + 16 * ks);
        acc[0] = __builtin_amdgcn_mfma_f32_32x32x16_bf16(*(const bf16x8*)(wa + 16 * ks), xb, acc[0], 0, 0, 0);
        if (NCH == 2) acc[NCH - 1] = __builtin_amdgcn_mfma_f32_32x32x16_bf16(*(const bf16x8*)(wb + 16 * ks), xb, acc[NCH - 1], 0, 0, 0);
    }
#pragma unroll
    for (int c = 0; c < NCH; ++c)
#pragma unroll
        for (int k = 0; k < 16; ++k) red[((wave * NCH + c) * 16 + k) * 64 + lane] = acc[c][k];
    __syncthreads();
    if (wave == 0) {
#pragma unroll 1
        for (int w = 1; w < 8; ++w) {
#pragma unroll
            for (int c = 0; c < NCH; ++c)
#pragma unroll
                for (int k = 0; k < 16; ++k) acc[c][k] += red[((w * NCH + c) * 16 + k) * 64 + lane];
        }
        E(acc, m0 + r, hh);
    }
    __syncthreads();
}
struct SEpiProj { bf16* P; const float* rstd; float* out; int n0;
    __device__ __forceinline__ void operator()(const f32x16 (&t)[1], int row, int hh) const {
        const float rs = rstd[row];
#pragma unroll
        for (int q = 0; q < 4; ++q) { const int col = n0 + 8 * q + 4 * hh; const f32x4 v = {t[0][4 * q] * rs, t[0][4 * q + 1] * rs, t[0][4 * q + 2] * rs, t[0][4 * q + 3] * rs};
            pg8::u32x2 w; w.x = cvtpk(v[0], v[1]); w.y = cvtpk(v[2], v[3]); *(pg8::u32x2*)(P + (size_t)row * NIN + col) = w;
            if (col >= 512) { float* d = pg8::side_dst(out, row, col); if (d) *(f32x4*)d = v; } }
    } };
template <bool FIRST> struct SEpiRes { const float* xs; float* out; bf16* XN; float* SSs; int n0;
    __device__ __forceinline__ void operator()(const f32x16 (&t)[1], int row, int hh) const {
        const int b = row - MP; float ss = 0.f;
#pragma unroll
        for (int q = 0; q < 4; ++q) { const int col = n0 + 8 * q + 4 * hh; float* op = out + (size_t)row * DM + col;
            const f32x4 base = FIRST ? *(const f32x4*)(xs + (size_t)b * DM + col) : *(const f32x4*)op;
            const f32x4 v = {base[0] + t[0][4 * q], base[1] + t[0][4 * q + 1], base[2] + t[0][4 * q + 2], base[3] + t[0][4 * q + 3]};
            *(f32x4*)op = v;
            if (FIRST) { pg8::u32x2 w; w.x = cvtpk(v[0], v[1]); w.y = cvtpk(v[2], v[3]); *(pg8::u32x2*)(XN + (size_t)row * DM + col) = w; }
            ss += (v[0] * v[0] + v[1] * v[1]) + (v[2] * v[2] + v[3] * v[3]); }
        ss += __shfl_xor(ss, 32);
        if (hh == 0) SSs[b * 32 + (n0 >> 5)] = ss;
    } };
struct SEpiSwiGLU { bf16* H; const float* SSs; int hc0;
    __device__ __forceinline__ void operator()(const f32x16 (&t)[2], int row, int hh) const {
        const int b = row - MP; const f32x4* sp = (const f32x4*)(SSs + b * 32);
        f32x4 a = sp[0];
#pragma unroll
        for (int i = 1; i < 8; ++i) a += sp[i];
        const float rs = 1.0f / sqrtf(((a[0] + a[1]) + (a[2] + a[3])) * (1.0f / DM) + pg8::RMS_EPS);
#pragma unroll
        for (int q = 0; q < 4; ++q) { float hv[4];
#pragma unroll
            for (int e = 0; e < 4; ++e) { const float g = t[0][4 * q + e] * rs, uu = t[1][4 * q + e] * rs; hv[e] = g * __builtin_amdgcn_rcpf(1.0f + __builtin_amdgcn_exp2f(-LOG2E * g)) * uu; }
            pg8::u32x2 w; w.x = cvtpk(hv[0], hv[1]); w.y = cvtpk(hv[2], hv[3]); *(pg8::u32x2*)(H + (size_t)row * DFF + hc0 + 8 * q + 4 * hh) = w; }
    } };
struct Args { const float* in[16]; float* out; unsigned char* ws; };

__global__ void __launch_bounds__(NWAVES * 64, 2) hymba_fwd(Args args) {
    extern __shared__ __attribute__((aligned(16))) unsigned char lds[];
    LAS unsigned char* const L = (LAS unsigned char*)lds;
    volatile LAS unsigned* const MISC = (volatile LAS unsigned*)(L + MISC_OFF);
#define FRESH_IDS() int tid = threadIdx.x; asm volatile("" : "+v"(tid)); const int lane = tid & 63, wave = __builtin_amdgcn_readfirstlane(tid >> 6); const int gw = vcu * NWAVES + wave; (void)lane; (void)gw
    const int G = gridDim.x; const int bx = blockIdx.x; const int vcu = (G % 8 == 0) ? (bx % 8) * (G / 8) + bx / 8 : bx;
    const int NGW = G * NWAVES;
    unsigned char* const ws = args.ws;
    const float* const x_p = args.in[0]; const float* const x_s = args.in[1]; const float* const cache_k = args.in[2]; const float* const cache_v = args.in[3];
    const float* const state_pool = args.in[4]; const float* const norm1 = args.in[5]; const float* const w_in = args.in[6]; const float* const sinks = args.in[7];
    const float* const w_pool = args.in[8]; const float* const pool_scale = args.in[9]; const float* const w_out = args.in[10]; const float* const norm2 = args.in[11];
    const float* const w_gate = args.in[12]; const float* const w_up = args.in[13]; const float* const w_down = args.in[14]; const float* const final_norm = args.in[15];
    float* const out = args.out;
    gu32* const ctl = (gu32*)(ws + WS_CTL);
    float* const RSTD = (float*)(ws + WS_RSTD); float* const SS2 = (float*)(ws + WS_SS2); float* const SS3 = (float*)(ws + WS_SS3);
    float* const SSs2 = (float*)(ws + WS_SS2 + 0x110000); float* const SSs3 = (float*)(ws + WS_SS3 + 0x110000);
    bf16* const Win_t = (bf16*)(ws + WS_WIN); bf16* const Wout_t = (bf16*)(ws + WS_WOUT); bf16* const Wgu_t = (bf16*)(ws + WS_WGU); bf16* const Wd_t = (bf16*)(ws + WS_WD);
    bf16* const XN = (bf16*)(ws + WS_XN); bf16* const PROJ = (bf16*)(ws + WS_PROJ); bf16* const MIX = (bf16*)(ws + WS_MIX); bf16* const HB = (bf16*)(ws + WS_H);

    for (int u = threadIdx.x; u < (LDS_BYTES - LDSCTL_OFF) / 4; u += NWAVES * 64) ((LAS unsigned*)(L + LDSCTL_OFF))[u] = 0u;
    __syncthreads();
    XcdBarrier bar = xcd_barrier_post((unsigned*)(ctl + CW_BAR), MISC + 8);

    {
        FRESH_IDS();
        LAS float* scr = (LAS float*)(L + RING_OFF + wave * 16384);
        constexpr int I_IN = (DM / 64) * (NIN / 32), I_OUT = (DM / 64) * (DM / 32), I_G = (DM / 64) * (DFF / 32), I_D = (DFF / 64) * (DM / 32);
        constexpr int NITEMS = I_IN + I_OUT + 2 * I_G + I_D;
        for (int it = gw; it < NITEMS; it += NGW) {
            int r = it;
            if (r < I_IN) { p0_transpose_item<0>(w_in, DM, NIN, norm1, Win_t, scr, r, lane); continue; } r -= I_IN;
            if (r < I_OUT) { p0_transpose_item<0>(w_out, DM, DM, nullptr, Wout_t, scr, r, lane); continue; } r -= I_OUT;
            if (r < I_G) { p0_transpose_item<1>(w_gate, DM, DFF, norm2, Wgu_t, scr, r, lane); continue; } r -= I_G;
            if (r < I_G) { p0_transpose_item<2>(w_up, DM, DFF, norm2, Wgu_t, scr, r, lane); continue; } r -= I_G;
            p0_transpose_item<0>(w_down, DFF, DM, nullptr, Wd_t, scr, r, lane);
        }
        for (int m = gw; m < MPAD; m += NGW) {
            GAS unsigned long long* o8 = (GAS unsigned long long*)(XN + (size_t)m * DM) + lane;
            if (m < MV) {
                const float* xrow = (m < MP) ? x_p + (size_t)m * DM : x_s + (size_t)(m - MP) * DM;
                const GAS f32x4* xr = (const GAS f32x4*)xrow + lane;
                f32x4 v[4]; float s = 0.f;
#pragma unroll
                for (int j = 0; j < 4; ++j) { v[j] = xr[64 * j]; s += (v[j].x * v[j].x + v[j].y * v[j].y) + (v[j].z * v[j].z + v[j].w * v[j].w); }
                const float rstd = 1.f / sqrtf(wave_sum(s) * (1.f / DM) + pg8::RMS_EPS);
                if (lane == 0) RSTD[m] = rstd;
#pragma unroll
                for (int j = 0; j < 4; ++j) o8[64 * j] = (unsigned long long)pk2(v[j].x, v[j].y) | ((unsigned long long)pk2(v[j].z, v[j].w) << 32);
            } else {
                if (lane == 0) RSTD[m] = 0.f;
#pragma unroll
                for (int j = 0; j < 4; ++j) o8[64 * j] = 0ull;
            }
        }
        {
            const int gt = gw * 64 + lane, NT = NGW * 64;
            const f32x4* ck4 = (const f32x4*)cache_k; const f32x4* cv4 = (const f32x4*)cache_v; const f32x4* sp4 = (const f32x4*)state_pool;
            f32x4* ok4 = (f32x4*)(out + pg8::OFF_KS); f32x4* ov4 = (f32x4*)(out + pg8::OFF_VS); f32x4* op4 = (f32x4*)(out + pg8::OFF_PS);
            for (int i = gt; i < 128 * 127 * 32; i += NT) { const int b = i / (127 * 32), r = i % (127 * 32); ok4[b * 4096 + r] = ck4[b * 4096 + 32 + r]; ov4[b * 4096 + r] = cv4[b * 4096 + 32 + r]; }
            for (int i = gt; i < 128 * 14 * 128; i += NT) { const int b = i / (14 * 128), r = i % (14 * 128); op4[b * 1920 + r] = sp4[b * 1920 + 128 + r]; }
        }
    }
    xcd_barrier(bar);

    {
        FRESH_IDS();
        pg8::Gemm g{XN, Win_t, MP, NIN, DM}; pg8::StaticOrder S; S.init(MP, NIN, G, bx);
        pg8::EpiProj E{PROJ, RSTD, out};
        pg8::gemm_phase<pg8::EpiProj, pg8::StaticOrder, true, true>(L + RING_OFF, g, S, E);
        for (int ti = (bx + G - 64 % G) % G; ti < 160; ti += G) {
            SEpiProj SE{PROJ, RSTD, out, (ti >> 2) * 32};
            small_tile<1>(XN, DM, MP + (ti & 3) * 32, Win_t, DM, (ti >> 2) * 32, 0, (LAS float*)(L + RING_OFF), wave, lane, SE);
        }
    }
    xcd_barrier(bar);

    {
        FRESH_IDS();
        for (int u = wave * G + vcu; u < 1280; u += NGW) {
            if (u < 1024) attn_unit<false>(PROJ, cache_k, cache_v, sinks, MIX, L + RING_OFF + wave * 20480, u >> 8, (u >> 7) & 1, u & 127, lane);
            else attn_unit<true>(PROJ, cache_k, cache_v, sinks, MIX, L + RING_OFF + wave * 20480, (u - 1024) & 127, (u - 1024) >> 7, 0, lane);
        }
        __syncthreads();
        LAS float* ms = (LAS float*)(L + RING_OFF + wave * 4096);
        for (int item = gw; item < (MV / 8) * 4; item += NGW) {
            const int rt = item >> 2, g = item & 3, w = 2 << g;
#pragma unroll
            for (int r = 0; r < 8; ++r) {
                const int row = rt * 8 + r;
#pragma unroll
                for (int hf = 0; hf < 2; ++hf) {
                    const int cc = lane + 64 * hf, c = g * 128 + cc;
                    const bf16* up = PROJ + (size_t)row * NIN + 768 + c;
                    const float self = bf1(*up); float sum = self, cnt;
                    if (row < MP) { const int t = row & 4095, n = (w - 1) < t ? (w - 1) : t; for (int k = 1; k <= n; ++k) sum += bf1(*(up - (size_t)k * NIN)); cnt = (float)(n + 1); }
                    else { const int b = row - MP; for (int j = 16 - w; j <= 14; ++j) sum += state_pool[(size_t)(b * 15 + j) * 512 + c]; cnt = (float)w; }
                    ms[cc * 8 + r] = sum / cnt - self;
                }
            }
            LDS_WAIT(); asm volatile("" ::: "memory");
            float a0[8], a1[8];
#pragma unroll
            for (int r = 0; r < 8; ++r) { a0[r] = 0.f; a1[r] = 0.f; }
            const float* wp = w_pool + (size_t)g * 128 * 128;
            for (int c = 0; c < 128; ++c) {
                const float w0 = wp[c * 128 + lane], w1 = wp[c * 128 + 64 + lane];
                const f32x4 ma = *(const LAS f32x4*)(ms + c * 8), mb = *(const LAS f32x4*)(ms + c * 8 + 4);
                a0[0] += ma.x * w0; a0[1] += ma.y * w0; a0[2] += ma.z * w0; a0[3] += ma.w * w0; a0[4] += mb.x * w0; a0[5] += mb.y * w0; a0[6] += mb.z * w0; a0[7] += mb.w * w0;
                a1[0] += ma.x * w1; a1[1] += ma.y * w1; a1[2] += ma.z * w1; a1[3] += ma.w * w1; a1[4] += mb.x * w1; a1[5] += mb.y * w1; a1[6] += mb.z * w1; a1[7] += mb.w * w1;
            }
            const float s0 = pool_scale[g * 128 + lane], s1 = pool_scale[g * 128 + 64 + lane];
#pragma unroll
            for (int r = 0; r < 8; ++r) { bf16* mp = MIX + (size_t)(rt * 8 + r) * DM + 512 + g * 128; mp[lane] = (bf16)f2bf(a0[r] * s0); mp[64 + lane] = (bf16)f2bf(a1[r] * s1); }
            LDS_WAIT(); asm volatile("" ::: "memory");
        }
    }
    xcd_barrier(bar);

    {
        FRESH_IDS();
        pg8::Gemm g{MIX, Wout_t, MP, DM, DM}; pg8::StaticOrder S; S.init(MP, DM, G, bx);
        pg8::EpiRes<true> E{x_p, x_s, out, XN, SS2};
        pg8::gemm_phase<pg8::EpiRes<true>, pg8::StaticOrder, true, true>(L + RING_OFF, g, S, E);
        for (int ti = bx; ti < 128; ti += G) {
            SEpiRes<true> SE{x_s, out, XN, SSs2, (ti >> 2) * 32};
            small_tile<1>(MIX, DM, MP + (ti & 3) * 32, Wout_t, DM, (ti >> 2) * 32, 0, (LAS float*)(L + RING_OFF), wave, lane, SE);
        }
    }
    xcd_barrier(bar);

    {
        FRESH_IDS();
        pg8::Gemm g{XN, Wgu_t, MP, 2 * DFF, DM}; pg8::StaticOrder S; S.init(MP, 2 * DFF, G, bx);
        pg8::EpiSwiGLU E{HB, SS2};
        pg8::gemm_phase<pg8::EpiSwiGLU, pg8::StaticOrder, true, true>(L + RING_OFF, g, S, E);
        for (int ti = (bx + G - 128 % G) % G; ti < 352; ti += (G >= 256 ? 128 : G)) {
            const int hc0 = (ti >> 2) * 32, nA = (hc0 >> 7) * 256 + (hc0 & 127);
            SEpiSwiGLU SE{HB, SSs2, hc0};
            small_tile<2>(XN, DM, MP + (ti & 3) * 32, Wgu_t, DM, nA, nA + 128, (LAS float*)(L + RING_OFF), wave, lane, SE);
        }
    }
    xcd_barrier(bar);

    {
        FRESH_IDS();
        pg8::Gemm g{HB, Wd_t, MP, DM, DFF}; pg8::StaticOrder S; S.init(MP, DM, G, bx);
        pg8::EpiRes<false> E{nullptr, nullptr, out, nullptr, SS3};
        pg8::gemm_phase<pg8::EpiRes<false>, pg8::StaticOrder, true, true>(L + RING_OFF, g, S, E);
        for (int ti = bx; ti < 128; ti += G) {
            SEpiRes<false> SE{nullptr, out, nullptr, SSs3, (ti >> 2) * 32};
            small_tile<1>(HB, DFF, MP + (ti & 3) * 32, Wd_t, DFF, (ti >> 2) * 32, 0, (LAS float*)(L + RING_OFF), wave, lane, SE);
        }
    }
    xcd_barrier(bar);

    {
        FRESH_IDS();
        const unsigned poison = xb_ld((unsigned*)(ctl + CW_BAR) + XB_TMO);
        for (int m = gw; m < MV; m += NGW) {
            f32x4 a;
            if (m < MP) { const f32x4* sp = (const f32x4*)(SS3 + (size_t)m * 16); a = (sp[0] + sp[1]) + (sp[2] + sp[3]); }
            else { const f32x4* sp = (const f32x4*)(SSs3 + (m - MP) * 32); a = ((sp[0] + sp[1]) + (sp[2] + sp[3])) + ((sp[4] + sp[5]) + (sp[6] + sp[7])); }
            float rs = 1.0f / sqrtf(((a[0] + a[1]) + (a[2] + a[3])) * (1.0f / DM) + pg8::RMS_EPS);
            if (poison) rs = __builtin_nanf("");
            GAS f32x4* xr = (GAS f32x4*)(out + (size_t)m * DM) + lane; const f32x4* gf = (const f32x4*)final_norm + lane;
#pragma unroll
            for (int j = 0; j < 4; ++j) { const f32x4 v = xr[64 * j]; xr[64 * j] = v * rs * gf[64 * j]; }
        }
    }
}

extern "C" void kernel_launch(void* const* d_in, const int* in_sizes, int n_in, void* d_out, int out_size, void* d_ws, size_t ws_size, hipStream_t stream) {
    static int grid = 0;
    if (grid == 0) {
        if (n_in != 16 || out_size != (int)pg8::OUT_TOTAL || ws_size < WS_END) { fprintf(stderr, "kernel_launch: unexpected shapes (n_in %d, out %d, ws %zu); nothing launched\n", n_in, out_size, ws_size); grid = -1; return; }
        int dev = 0, cus = 0, per_cu = 0;
        if (hipGetDevice(&dev) != hipSuccess || hipDeviceGetAttribute(&cus, hipDeviceAttributeMultiprocessorCount, dev) != hipSuccess) { grid = -1; return; }
        if (hipFuncSetAttribute((const void*)hymba_fwd, hipFuncAttributeMaxDynamicSharedMemorySize, LDS_BYTES) != hipSuccess) { fprintf(stderr, "kernel_launch: hipFuncSetAttribute failed\n"); grid = -1; return; }
        if (hipOccupancyMaxActiveBlocksPerMultiprocessor(&per_cu, (const void*)hymba_fwd, NWAVES * 64, LDS_BYTES) != hipSuccess || per_cu < 1)
            fprintf(stderr, "kernel_launch: note: occupancy query reports %d workgroups per CU\n", per_cu);
        (void)hipGetLastError();
        grid = cus;
    }
    if (grid < 0) return;
    if (hipMemsetAsync((char*)d_ws + WS_CTL, 0, CTL_ZERO_BYTES, stream) != hipSuccess) { fprintf(stderr, "kernel_launch: hipMemsetAsync failed\n"); return; }
    Args a{};
    for (int i = 0; i < 16; ++i) a.in[i] = (const float*)d_in[i];
    a.out = (float*)d_out; a.ws = (unsigned char*)d_ws;
    hipLaunchKernelGGL(hymba_fwd, dim3(grid), dim3(NWAVES * 64), LDS_BYTES, stream, a);
}
```

```cpp
#include <hip/hip_runtime.h>
#include <cstdio>
#include <cstdint>
namespace pg8 {
#define PG8_LAS __attribute__((address_space(3)))
typedef unsigned short bf16_t;
typedef short bf16x8 __attribute__((ext_vector_type(8)));
typedef float f32x4 __attribute__((ext_vector_type(4)));
typedef unsigned u32x4 __attribute__((ext_vector_type(4)));
constexpr int BM = 256, BK = 64, HALF = 128, HTB = HALF * BK * 2  , STAGE_BYTES = 8 * HTB, NXCD = 8, WGM = 8;

__host__ __device__ __forceinline__ int lds_byte(int r, int c) { const int st = (r >> 4) * 2 + (c >> 5), rr = r & 15, cc = c & 31, ob = rr * 64 + cc * 2; return st * 1024 + (ob ^ (((ob >> 9) & 1) << 5)); }
__host__ __device__ __forceinline__ void stage_rc(int b, int& R, int& C) { const int st = b / 1024, sb = b % 1024, swz = sb ^ (((sb >> 9) & 1) << 5); R = (st >> 1) * 16 + swz / 64; C = (st & 1) * 32 + (swz % 64) / 2; }
__host__ __device__ __forceinline__ int perm32(int rho) { const int n = rho >> 4, i = rho & 15; return 8 * (i >> 2) + 4 * n + (i & 3); }

struct Unit { int pm, pn; };
struct Gemm { const bf16_t* A; const bf16_t* Bt; int M, N, K; };

struct StaticOrder {
    int nM, nN, nwg, G, c;
    __host__ __device__ void init(int M, int N, int G_, int c_) { nM = M / BM; nN = N / BM; nwg = nM * nN; G = G_; c = c_; }
    __host__ __device__ bool next(int i, Unit& u) const {
        const long L = (long)i * G + c; if (L >= nwg) return false;
        int wgid = (int)L; { const int q = nwg / NXCD, r = nwg % NXCD, xcd = wgid % NXCD, off = wgid / NXCD; wgid = (xcd < r ? xcd * (q + 1) : r * (q + 1) + (xcd - r) * q) + off; }
        const int nig = WGM * nN, gid = wgid / nig, fm = gid * WGM, gsz = (nM - fm) < WGM ? (nM - fm) : WGM;
        u.pm = fm + ((wgid % nig) % gsz); u.pn = (wgid % nig) / gsz; return true;
    }
    __device__ __forceinline__ void a_ready(const Unit&) const {}
    __device__ __forceinline__ void done(const Unit&) const {}
};

__device__ __forceinline__ unsigned cvt_pk_bf16(float lo, float hi) { unsigned r; asm volatile("v_cvt_pk_bf16_f32 %0, %1, %2" : "=v"(r) : "v"(lo), "v"(hi)); return r; }
typedef float f32x2 __attribute__((ext_vector_type(2)));

typedef unsigned u32x2 __attribute__((ext_vector_type(2)));
constexpr int ROWS_P = 16384, ROWS_V = 16512;
constexpr size_t OFF_Y = 0, OFF_KP = 16908288, OFF_VP = 16973824, OFF_PP = 17039360, OFF_KS = 17070080, OFF_VS = 19167232, OFF_PS = 21264384, OUT_TOTAL = 22247424;
constexpr float RMS_EPS = 1e-5f;

__device__ __forceinline__ float* side_dst(float* out, int row, int col) {
    if (row < ROWS_P) { const int b = row >> 12, t = row & 4095;
        if (col < 768) { if (t < 3968) return nullptr; const bool isv = col >= 640; return out + (isv ? OFF_VP : OFF_KP) + (size_t)((b * 128 + (t - 3968)) * 128 + (col - (isv ? 640 : 512))); }
        if (t < 4081) return nullptr; return out + OFF_PP + (size_t)((b * 15 + (t - 4081)) * 512 + (col - 768)); }
    if (row < ROWS_V) { const int b = row - ROWS_P;
        if (col < 768) { const bool isv = col >= 640; return out + (isv ? OFF_VS : OFF_KS) + (size_t)((b * 128 + 127) * 128 + (col - (isv ? 640 : 512))); }
        return out + OFF_PS + (size_t)((b * 15 + 14) * 512 + (col - 768)); }
    return nullptr;
}
struct EpiProj {
    static constexpr bool PERM = true, AFTER_DRAIN = false;
    bf16_t* P; const float* rstd; float* out;
    __device__ __forceinline__ void operator()(const f32x4 (&acc)[2][2][4][2], const Unit& u, int wr, int wc, int fr, int fq) const {
        const int col0 = u.pn * BM + wc * 32 + 8 * fq;
        const bool side = (u.pn >= 2) && (u.pm == 64 || (u.pm & 15) == 15);
#pragma unroll
        for (int ai = 0; ai < 2; ++ai)
#pragma unroll
            for (int m = 0; m < 4; ++m) {
                const int row = u.pm * BM + ai * HALF + wr * 64 + m * 16 + fr;
                const float rs = rstd[row];
                bf16_t* rowp = P + (size_t)row * 1280 + col0;
#pragma unroll
                for (int bj = 0; bj < 2; ++bj) {
                    const f32x4 v0 = acc[ai][bj][m][0] * rs, v1 = acc[ai][bj][m][1] * rs;
                    u32x4 w; w.x = cvt_pk_bf16(v0[0], v0[1]); w.y = cvt_pk_bf16(v0[2], v0[3]); w.z = cvt_pk_bf16(v1[0], v1[1]); w.w = cvt_pk_bf16(v1[2], v1[3]);
                    *(u32x4*)(rowp + bj * HALF) = w;
                    if (side) { float* d = side_dst(out, row, col0 + bj * HALF); if (d) { *(f32x4*)d = v0; *(f32x4*)(d + 4) = v1; } }
                }
            }
    }
};
template <bool FIRST> struct EpiRes {
    static constexpr bool PERM = false, AFTER_DRAIN = false;
    const float* xp; const float* xs; float* out; bf16_t* XN; float* SS;
    __device__ __forceinline__ void operator()(const f32x4 (&acc)[2][2][4][2], const Unit& u, int wr, int wc, int fr, int fq) const {
        const int col0 = u.pn * BM + wc * 32 + 4 * fq;
#pragma unroll
        for (int ai = 0; ai < 2; ++ai)
#pragma unroll
            for (int m = 0; m < 4; ++m) {
                const int row = u.pm * BM + ai * HALF + wr * 64 + m * 16 + fr;
                if (row < ROWS_V) {
                    float* orow = out + (size_t)row * 1024 + col0;
                    const float* xr = FIRST ? ((row < ROWS_P) ? xp + (size_t)row * 1024 : xs + (size_t)(row - ROWS_P) * 1024) + col0 : orow;
                    float ss = 0.f;
#pragma unroll
                    for (int bj = 0; bj < 2; ++bj)
#pragma unroll
                        for (int n = 0; n < 2; ++n) {
                            const int c = bj * HALF + n * 16;
                            const f32x4 v = *(const f32x4*)(xr + c) + acc[ai][bj][m][n];
                            *(f32x4*)(orow + c) = v;
                            if (FIRST) { u32x2 w; w.x = cvt_pk_bf16(v[0], v[1]); w.y = cvt_pk_bf16(v[2], v[3]); *(u32x2*)(XN + (size_t)row * 1024 + col0 + c) = w; }
                            ss += (v[0] * v[0] + v[1] * v[1]) + (v[2] * v[2] + v[3] * v[3]);
                        }
                    ss += __shfl_xor(ss, 16); ss += __shfl_xor(ss, 32);
                    if (fq == 0) SS[(size_t)row * 16 + u.pn * 4 + wc] = ss;
                }
            }
    }
};
struct EpiSwiGLU {
    static constexpr bool PERM = true, AFTER_DRAIN = false;
    bf16_t* H; const float* SS;
    __device__ __forceinline__ void operator()(const f32x4 (&acc)[2][2][4][2], const Unit& u, int wr, int wc, int fr, int fq) const {
        const int colh = u.pn * HALF + wc * 32 + 8 * fq;
#pragma unroll
        for (int ai = 0; ai < 2; ++ai)
#pragma unroll
            for (int m = 0; m < 4; ++m) {
                const int row = u.pm * BM + ai * HALF + wr * 64 + m * 16 + fr;
                const f32x4* sp = (const f32x4*)(SS + (size_t)row * 16);
                const f32x4 a = (sp[0] + sp[1]) + (sp[2] + sp[3]);
                const float rs = 1.0f / sqrtf(((a[0] + a[1]) + (a[2] + a[3])) * (1.0f / 1024.0f) + RMS_EPS);
                float hv[8];
#pragma unroll
                for (int n = 0; n < 2; ++n)
#pragma unroll
                    for (int j = 0; j < 4; ++j) {
                        const float g = acc[ai][0][m][n][j] * rs, uu = acc[ai][1][m][n][j] * rs;
                        const float sg = g * __builtin_amdgcn_rcpf(1.0f + __builtin_amdgcn_exp2f(-1.4426950408889634f * g));
                        hv[n * 4 + j] = sg * uu;
                    }
                u32x4 w; w.x = cvt_pk_bf16(hv[0], hv[1]); w.y = cvt_pk_bf16(hv[2], hv[3]); w.z = cvt_pk_bf16(hv[4], hv[5]); w.w = cvt_pk_bf16(hv[6], hv[7]);
                *(u32x4*)(H + (size_t)row * 2816 + colh) = w;
            }
    }
};

template <class Epi, class Sched, bool ALIGN_EPI = false, bool SP2 = false>
__device__ __forceinline__ void gemm_phase(PG8_LAS unsigned char* lds, const Gemm g, const Sched& S, const Epi& E) {
    int tid_ = threadIdx.x; asm volatile("" : "+v"(tid_));
    const int tid = tid_, wid = __builtin_amdgcn_readfirstlane(tid >> 6), lane = tid & 63, wr = wid >> 2, wc = wid & 3, fr = lane & 15, fq = lane >> 4;
    const int K = g.K, nt = K / BK;
    unsigned voffA[2], voffB[2];
#pragma unroll
    for (int i = 0; i < 2; ++i) { int R, C; stage_rc(tid * 16 + i * 8192, R, C); const int Rb = Epi::PERM ? ((R & ~31) + perm32(R & 31)) : R;
        voffA[i] = (unsigned)(R * K + C) * 2u; voffB[i] = (unsigned)(Rb * K + C) * 2u; }
    const size_t kstep = (size_t)(BK * 2);
    const size_t hstep = (size_t)HALF * K * 2;
    const size_t tstep = 2 * hstep;
    const unsigned ldsw = (unsigned)wid * 1024u;
    const int aoff = lds_byte(wr * 64 + fr, fq * 8), boff = lds_byte(wc * 32 + fr, fq * 8);
#define PG8_SA(b, h) (((b) * 2 + (h)) * HTB)
#define PG8_SB(b, h) ((4 + (b) * 2 + (h)) * HTB)
#define PG8_STAGE(bufoff, gbase, voff) do { _Pragma("unroll") for (int _i = 0; _i < 2; ++_i) \
        __builtin_amdgcn_global_load_lds((const unsigned*)((const char*)(gbase) + (voff)[_i]), (PG8_LAS unsigned*)(lds + (bufoff) + ldsw + _i * 8192), 16, 0, 0); } while (0)
#define PG8_LDA(dst, b, h) do { _Pragma("unroll") for (int m = 0; m < 4; ++m) _Pragma("unroll") for (int k = 0; k < 2; ++k) dst[m][k] = *(const PG8_LAS bf16x8*)(lds + PG8_SA(b, h) + aoff + m * 2048 + k * 1024); } while (0)
#define PG8_LDB(dst, b, h) do { _Pragma("unroll") for (int n = 0; n < 2; ++n) _Pragma("unroll") for (int k = 0; k < 2; ++k) dst[n][k] = *(const PG8_LAS bf16x8*)(lds + PG8_SB(b, h) + boff + n * 2048 + k * 1024); } while (0)
#define PG8_MMA(ai, bj, At, Bt) do { __builtin_amdgcn_s_setprio(1); _Pragma("unroll") for (int m = 0; m < 4; ++m) _Pragma("unroll") for (int n = 0; n < 2; ++n) _Pragma("unroll") for (int k = 0; k < 2; ++k) \
        acc[ai][bj][m][n] = __builtin_amdgcn_mfma_f32_16x16x32_bf16(Bt[n][k], At[m][k], acc[ai][bj][m][n], 0, 0, 0); __builtin_amdgcn_s_setprio(0); } while (0)
#define PG8_WAIT_V(n) asm volatile("s_waitcnt vmcnt(" #n ")" ::: "memory")
#define PG8_WAIT_L(n) asm volatile("s_waitcnt lgkmcnt(" #n ")" ::: "memory")
#define PG8_BAR __builtin_amdgcn_s_barrier()
#define PG8_SCHED __builtin_amdgcn_sched_barrier(0)
    Unit cur, nxt; int ui = 0;
    if (!S.next(0, cur)) return;
    f32x4 acc[2][2][4][2];
#pragma unroll
    for (int a = 0; a < 2; ++a)
#pragma unroll
        for (int b = 0; b < 2; ++b)
#pragma unroll
            for (int m = 0; m < 4; ++m)
#pragma unroll
                for (int n = 0; n < 2; ++n) acc[a][b][m][n] = (f32x4){0.f, 0.f, 0.f, 0.f};
    bf16x8 At[4][2], B0[2][2], B1[2][2];
    const char* cA = (const char*)g.A + (size_t)cur.pm * tstep; const char* cB = (const char*)g.Bt + (size_t)cur.pn * tstep;
    S.a_ready(cur);
    if constexpr (SP2) {
        PG8_STAGE(PG8_SB(0, 0), cB, voffB); PG8_STAGE(PG8_SB(0, 1), cB + hstep, voffB); PG8_STAGE(PG8_SA(0, 0), cA, voffA); PG8_STAGE(PG8_SA(0, 1), cA + hstep, voffA);
        if (wr == 1) PG8_BAR;
        PG8_WAIT_V(2); PG8_BAR;
        PG8_STAGE(PG8_SB(1, 0), cB + kstep, voffB); PG8_STAGE(PG8_SA(1, 0), cA + kstep, voffA); PG8_STAGE(PG8_SB(1, 1), cB + hstep + kstep, voffB);
        PG8_WAIT_V(6); PG8_BAR;
    } else {
        PG8_STAGE(PG8_SB(0, 0), cB, voffB); PG8_STAGE(PG8_SA(0, 0), cA, voffA); PG8_STAGE(PG8_SB(0, 1), cB + hstep, voffB); PG8_STAGE(PG8_SA(0, 1), cA + hstep, voffA);
        if (wr == 1) PG8_BAR;
        PG8_WAIT_V(4); PG8_BAR;
        PG8_STAGE(PG8_SB(1, 0), cB + kstep, voffB); PG8_STAGE(PG8_SA(1, 0), cA + kstep, voffA); PG8_STAGE(PG8_SB(1, 1), cB + hstep + kstep, voffB);
        PG8_WAIT_V(6); PG8_BAR;
    }
    for (;;) {
        const bool has_next = S.next(ui + 1, nxt);
        const char* nA = has_next ? (const char*)g.A + (size_t)nxt.pm * tstep : cA; const char* nB = has_next ? (const char*)g.Bt + (size_t)nxt.pn * tstep : cB;
        for (int t = 0; t < nt; t += 2) {
            const bool last = (t == nt - 2);
            const char* a1 = cA + (size_t)(t + 1) * kstep;
            const char* a2 = last ? nA : cA + (size_t)(t + 2) * kstep; const char* b2 = last ? nB : cB + (size_t)(t + 2) * kstep;
            const char* a3 = a2 + kstep; const char* b3 = b2 + kstep;
            if (last && has_next) S.a_ready(nxt);
            if constexpr (SP2) {
            PG8_LDB(B0, 0, 0); PG8_LDB(B1, 0, 1); PG8_SCHED; PG8_LDA(At, 0, 0); PG8_STAGE(PG8_SA(1, 1), a1 + hstep, voffA);
            PG8_WAIT_V(8); PG8_WAIT_L(0); PG8_BAR; PG8_MMA(0, 0, At, B0); PG8_MMA(0, 1, At, B1); PG8_BAR; PG8_SCHED;
            PG8_LDA(At, 0, 1); PG8_STAGE(PG8_SB(0, 0), b2, voffB); PG8_STAGE(PG8_SB(0, 1), b2 + hstep, voffB); PG8_STAGE(PG8_SA(0, 0), a2, voffA);
            PG8_WAIT_V(8); PG8_WAIT_L(0); PG8_BAR; PG8_MMA(1, 0, At, B0); PG8_MMA(1, 1, At, B1); PG8_BAR; PG8_SCHED;
            PG8_LDB(B0, 1, 0); PG8_LDB(B1, 1, 1); PG8_SCHED; PG8_LDA(At, 1, 0); PG8_STAGE(PG8_SA(0, 1), a2 + hstep, voffA);
            PG8_WAIT_V(8); PG8_WAIT_L(0); PG8_BAR; PG8_MMA(0, 0, At, B0); PG8_MMA(0, 1, At, B1); PG8_BAR; PG8_SCHED;
            PG8_LDA(At, 1, 1); PG8_STAGE(PG8_SB(1, 0), b3, voffB); PG8_STAGE(PG8_SB(1, 1), b3 + hstep, voffB); PG8_STAGE(PG8_SA(1, 0), a3, voffA);
            PG8_WAIT_V(8); PG8_WAIT_L(0); PG8_BAR; PG8_MMA(1, 0, At, B0); PG8_MMA(1, 1, At, B1); PG8_BAR; PG8_SCHED;
            } else {
            PG8_LDB(B0, 0, 0); PG8_SCHED; PG8_LDA(At, 0, 0); PG8_STAGE(PG8_SA(1, 1), a1 + hstep, voffA);
            PG8_WAIT_L(8); PG8_BAR; PG8_WAIT_L(0); PG8_MMA(0, 0, At, B0); PG8_BAR; PG8_SCHED;
            PG8_LDB(B1, 0, 1); PG8_STAGE(PG8_SB(0, 0), b2, voffB);
            PG8_BAR; PG8_WAIT_L(0); PG8_MMA(0, 1, At, B1); PG8_BAR;
            PG8_LDA(At, 0, 1); PG8_STAGE(PG8_SA(0, 0), a2, voffA);
            PG8_BAR; PG8_WAIT_L(0); PG8_MMA(1, 0, At, B0); PG8_BAR; PG8_SCHED;
            PG8_STAGE(PG8_SB(0, 1), b2 + hstep, voffB);
            PG8_WAIT_V(6); PG8_BAR; PG8_MMA(1, 1, At, B1); PG8_BAR;
            PG8_LDB(B0, 1, 0); PG8_SCHED; PG8_LDA(At, 1, 0); PG8_STAGE(PG8_SA(0, 1), a2 + hstep, voffA);
            PG8_WAIT_L(8); PG8_BAR; PG8_WAIT_L(0); PG8_MMA(0, 0, At, B0); PG8_BAR; PG8_SCHED;
            PG8_LDB(B1, 1, 1); PG8_STAGE(PG8_SB(1, 0), b3, voffB);
            PG8_BAR; PG8_WAIT_L(0); PG8_MMA(0, 1, At, B1); PG8_BAR;
            PG8_LDA(At, 1, 1); PG8_STAGE(PG8_SA(1, 0), a3, voffA);
            PG8_BAR; PG8_WAIT_L(0); PG8_MMA(1, 0, At, B0); PG8_BAR; PG8_SCHED;
            PG8_STAGE(PG8_SB(1, 1), b3 + hstep, voffB);
            PG8_WAIT_V(6); PG8_BAR; PG8_MMA(1, 1, At, B1); PG8_BAR;
            }
        }
        if constexpr (ALIGN_EPI) { if (wr == 0) PG8_BAR; }
        if constexpr (!Epi::AFTER_DRAIN) { E(acc, cur, wr, wc, fr, fq); S.done(cur); }
        if (!has_next) break;
#pragma unroll
        for (int a = 0; a < 2; ++a)
#pragma unroll
            for (int b = 0; b < 2; ++b)
#pragma unroll
                for (int m = 0; m < 4; ++m)
#pragma unroll
                    for (int n = 0; n < 2; ++n) acc[a][b][m][n] = (f32x4){0.f, 0.f, 0.f, 0.f};
        cur = nxt; cA = nA; cB = nB; ++ui;
        if constexpr (ALIGN_EPI) { if (wr == 1) PG8_BAR; }
    }
    PG8_WAIT_V(0);
    if constexpr (!ALIGN_EPI) { if (wr == 0) PG8_BAR; }
    PG8_BAR;
    if constexpr (Epi::AFTER_DRAIN) { E.fused(acc, cur, wr, wc, fr, fq, lds, wid, lane); S.done(cur); }
#undef PG8_SA
#undef PG8_SB
#undef PG8_STAGE
#undef PG8_LDA
#undef PG8_LDB
#undef PG8_MMA
#undef PG8_WAIT_V
#undef PG8_WAIT_L
#undef PG8_BAR
#undef PG8_SCHED
}
}
#define GAS __attribute__((address_space(1)))
#define LAS __attribute__((address_space(3)))
typedef unsigned short bf16;
typedef unsigned v4u __attribute__((ext_vector_type(4)));
typedef float f32x4 __attribute__((ext_vector_type(4)));
typedef short bf16x8 __attribute__((ext_vector_type(8)));
typedef GAS unsigned gu32;
typedef GAS unsigned long long gu64;
#define RLX_AGENT __ATOMIC_RELAXED, __HIP_MEMORY_SCOPE_AGENT
#define LDS_WAIT() asm volatile("s_waitcnt lgkmcnt(0)" ::: "memory")
#define VM_WAIT() asm volatile("s_waitcnt vmcnt(0)" ::: "memory")
__device__ __forceinline__ unsigned long long rt() { return __builtin_amdgcn_s_memrealtime(); }
__device__ __forceinline__ unsigned f2bf(float f) { unsigned u = __builtin_bit_cast(unsigned, f); return (u + 0x7fffu + ((u >> 16) & 1u)) >> 16; }
__device__ __forceinline__ unsigned pk2(float lo, float hi) { return f2bf(lo) | (f2bf(hi) << 16); }

#define XB_TMO      128
#define XB_XCNT(j)  (256  + 64 * (j))
#define XB_XSUB(j)  (1280 + 64 * (j))
#define XB_XGEN(j)  (2304 + 64 * (j))
#define XB_TOP      3328
#define XB_TOPGEN   3392
#define XCD_BAR_WORDS 3456
#define XB_SPIN_CAP (1u << 18)

__device__ __forceinline__ unsigned xb_ld(unsigned* p)              { return __hip_atomic_load(p, __ATOMIC_RELAXED, __HIP_MEMORY_SCOPE_AGENT); }
__device__ __forceinline__ unsigned xb_add(unsigned* p, unsigned v) { return __hip_atomic_fetch_add(p, v, __ATOMIC_RELAXED, __HIP_MEMORY_SCOPE_AGENT); }
__device__ __forceinline__ unsigned xb_xcc_id() { return (unsigned)__builtin_amdgcn_s_getreg((3 << 11) | 20) & 0xFu; }
#define XB_SPIN(cond, bar) do { unsigned _sp = 0; while (cond) { __builtin_amdgcn_s_sleep(1); \
    if ((++_sp & 255u) == 0u) { if (xb_ld(&(bar)[XB_TMO])) break; if (_sp > XB_SPIN_CAP) { atomicAdd(&(bar)[XB_TMO], 1u); break; } } } } while (0)

struct XcdBarrier {
    unsigned* bar; unsigned x;
    volatile LAS unsigned* st;
};

__device__ __forceinline__ XcdBarrier xcd_barrier_post(unsigned* bar, volatile LAS unsigned* st) {
    XcdBarrier b; b.bar = bar; b.x = xb_xcc_id(); b.st = st;
    if (threadIdx.x == 0) (void)xb_add(&bar[XB_XCNT(b.x)], 1u);
    return b;
}
__device__ __forceinline__ void xcd_barrier_complete(unsigned* bar, unsigned x, unsigned& nloc, unsigned& nx) {
    const unsigned G = gridDim.x * gridDim.y * gridDim.z;
    unsigned sum, cnt, mine, sp = 0u;
    for (;;) {
        sum = 0u; cnt = 0u; mine = 0u;
#pragma unroll
        for (unsigned j = 0; j < 16; ++j) { const unsigned c = xb_ld(&bar[XB_XCNT(j)]); sum += c; cnt += (c > 0u) ? 1u : 0u; mine = (j == x) ? c : mine; }
        if (sum == G) break;
        __builtin_amdgcn_s_sleep(1);
        if ((++sp & 255u) == 0u) { if (xb_ld(&bar[XB_TMO])) break; if (sp > XB_SPIN_CAP) { atomicAdd(&bar[XB_TMO], 1u); break; } }
    }
    nloc = mine > 0u ? mine : 1u; nx = cnt > 0u ? cnt : 1u;
}

__device__ __forceinline__ void xcd_barrier(const XcdBarrier& b) {
    asm volatile("s_waitcnt vmcnt(0)" ::: "memory");
    __syncthreads();
    if (threadIdx.x == 0) {
        unsigned* bar = b.bar;
        __builtin_amdgcn_s_waitcnt(0);
        unsigned nloc = b.st[0], nx = b.st[1];
        if (nloc == 0u) { xcd_barrier_complete(bar, b.x, nloc, nx); b.st[0] = nloc; b.st[1] = nx; }
        const unsigned old = xb_add(&bar[XB_XSUB(b.x)], 1u);
        const unsigned gen = old / nloc;
        if (old + 1u == (gen + 1u) * nloc) {
            __builtin_amdgcn_fence(__ATOMIC_RELEASE, "agent");
            asm volatile("s_waitcnt vmcnt(0)" ::: "memory");
            const unsigned og = xb_add(&bar[XB_TOP], 1u);
            const unsigned tg = og / nx;
            if (og + 1u == (tg + 1u) * nx) xb_add(&bar[XB_TOPGEN], 1u);
            else XB_SPIN(xb_ld(&bar[XB_TOPGEN]) == tg, bar);
            __builtin_amdgcn_fence(__ATOMIC_ACQUIRE, "agent");
            xb_add(&bar[XB_XGEN(b.x)], 1u);
            asm volatile("s_waitcnt vmcnt(0)" ::: "memory");
        } else {
            XB_SPIN(xb_ld(&bar[XB_XGEN(b.x)]) == gen, bar);
            __builtin_amdgcn_fence(__ATOMIC_ACQUIRE, "agent");
            asm volatile("s_waitcnt vmcnt(0)" ::: "memory");
        }
    }
    __syncthreads();
}

constexpr int NWAVES = 8;
constexpr int DM = 1024, MP = 16384, MSMP = 128, MV = 16512, MPAD = 16640, NIN = 1280, DFF = 2816;
constexpr size_t MiB = 1u << 20;
constexpr size_t WS_CTL = 0, CTL_ZERO_BYTES = 65536;
constexpr size_t WS_RSTD = 1 * MiB;
constexpr size_t WS_SS2 = 2 * MiB, WS_SS3 = 4 * MiB;
constexpr size_t WS_WIN = 6 * MiB, WS_WOUT = 9 * MiB, WS_WGU = 11 * MiB, WS_WD = 22 * MiB;
constexpr size_t WS_WPOOL = 27 * MiB + 512 * 1024;
constexpr size_t WS_XN = 28 * MiB;
constexpr size_t WS_PROJ = 61 * MiB;
constexpr size_t WS_MIX = 102 * MiB;
constexpr size_t WS_H = 135 * MiB;
constexpr size_t WS_END = 225 * MiB;
static_assert(WS_WIN + (size_t)NIN * DM * 2 <= WS_WOUT && WS_WGU + (size_t)2 * DFF * DM * 2 <= WS_WD && WS_WD + (size_t)DM * DFF * 2 <= WS_XN, "ws map: weights");
static_assert(WS_XN + (size_t)MPAD * DM * 2 <= WS_PROJ && WS_PROJ + (size_t)MPAD * NIN * 2 <= WS_MIX && WS_MIX + (size_t)MPAD * DM * 2 <= WS_H && WS_H + (size_t)MPAD * DFF * 2 <= WS_END, "ws map: activations");
static_assert(WS_SS2 + (size_t)MPAD * 64 <= WS_SS3 && WS_SS3 + (size_t)MPAD * 64 <= WS_WIN, "ws map: stats");
constexpr int CW_BAR = 4096;
static_assert((CW_BAR + XCD_BAR_WORDS) * 4 <= (int)CTL_ZERO_BYTES, "barrier words inside the memset region");
constexpr int RING_OFF = 0, RING_BYTES = 131072, LDSCTL_OFF = RING_BYTES, MISC_OFF = LDSCTL_OFF + 320, LDS_BYTES = 147456;

__device__ __forceinline__ float wave_sum(float v) {
#pragma unroll
    for (int o = 1; o < 64; o <<= 1) v += __shfl_xor(v, o);
    return v;
}
__device__ __forceinline__ float bflo(unsigned w) { return __builtin_bit_cast(float, w << 16); }
__device__ __forceinline__ float bfhi(unsigned w) { return __builtin_bit_cast(float, w & 0xffff0000u); }
__device__ __forceinline__ float bf1(bf16 b) { return __builtin_bit_cast(float, (unsigned)b << 16); }

template <int MODE>
__device__ __forceinline__ void p0_transpose_item(const float* W, int K, int N, const float* gain, bf16* WT, LAS float* scr, int item, int lane) {
    const int nblk = N / 32, kb = item / nblk, nb = item % nblk, k0 = 64 * kb, n0 = 32 * nb;
#pragma unroll 8
    for (int i = 0; i < 32; ++i) { const int kk = 2 * i + (lane >> 5); float w = W[(size_t)(k0 + kk) * N + n0 + (lane & 31)]; if (gain) w *= gain[k0 + kk]; scr[kk * 33 + (lane & 31)] = w; }
    LDS_WAIT(); asm volatile("" ::: "memory");
    const int c = lane & 7;
#pragma unroll
    for (int j = 0; j < 4; ++j) { const int n = (lane >> 3) + 8 * j; const LAS float* s = scr + (8 * c) * 33 + n;
        v4u o; o.x = pk2(s[0 * 33], s[1 * 33]); o.y = pk2(s[2 * 33], s[3 * 33]); o.z = pk2(s[4 * 33], s[5 * 33]); o.w = pk2(s[6 * 33], s[7 * 33]);
        const int nn = n0 + n, orow = (MODE == 0) ? nn : ((nn >> 7) * 256 + (MODE == 2 ? 128 : 0) + (nn & 127));
        *(GAS v4u*)(WT + (size_t)orow * K + k0 + 8 * c) = o; }
    LDS_WAIT(); asm volatile("" ::: "memory");
}


typedef float f32x16 __attribute__((ext_vector_type(16)));
typedef unsigned short u16x8 __attribute__((ext_vector_type(8)));
__device__ __forceinline__ unsigned cvtpk(float lo, float hi) { typedef float f2_t __attribute__((ext_vector_type(2))); typedef __bf16 b2_t __attribute__((ext_vector_type(2)));
    f2_t v = {lo, hi}; b2_t b = __builtin_convertvector(v, b2_t); return __builtin_bit_cast(unsigned, b); }
__device__ __forceinline__ bf16x8 pack8(float a0, float a1, float a2, float a3, float a4, float a5, float a6, float a7) {
    v4u w; w.x = cvtpk(a0, a1); w.y = cvtpk(a2, a3); w.z = cvtpk(a4, a5); w.w = cvtpk(a6, a7); return __builtin_bit_cast(bf16x8, w); }
constexpr float LOG2E = 1.4426950408889634f;

template <bool SAMPLE>
__device__ __forceinline__ void attn_unit(const bf16* PROJ, const float* cache_k, const float* cache_v, const float* sinks, bf16* MIX, LAS unsigned char* vst, int b, int kvh, int qb, int lane) {
    const int r = lane & 31, hh = lane >> 5;
    const int nskip = SAMPLE ? 0 : (qb < 4 ? 4 - qb : 0);
    const size_t R0 = SAMPLE ? 0 : (size_t)b * 4096; const int q0 = qb * 32;
    const size_t srow = (size_t)MP + b;
    const bf16x8 zero8 = {0, 0, 0, 0, 0, 0, 0, 0};
#pragma unroll 2
    for (int it = 0; it < 20; ++it) {
        const int rr = 8 * it + (lane >> 3), c = lane & 7;
        v4u w = {0u, 0u, 0u, 0u};
        if (!SAMPLE) { if (it >= 4 * nskip) w = *(const v4u*)(PROJ + (R0 + q0 - 128 + rr) * NIN + 640 + kvh * 64 + 8 * c); }
        else if (it < 16) { const f32x4* vp = (const f32x4*)(cache_v + ((size_t)(b * 128 + rr) * 2 + kvh) * 64 + 8 * c); const f32x4 a = vp[0], d = vp[1];
            w.x = cvtpk(a[0], a[1]); w.y = cvtpk(a[2], a[3]); w.z = cvtpk(d[0], d[1]); w.w = cvtpk(d[2], d[3]); }
        else if (it == 16) { const v4u vn = *(const v4u*)(PROJ + srow * NIN + 640 + kvh * 64 + 8 * c); if (rr == 128) w = vn; }
        *(LAS v4u*)(vst + rr * 128 + c * 16) = w;
    }
    const LAS unsigned short* vrd = (const LAS unsigned short*)(vst + (4 * hh) * 128 + r * 2);
    constexpr int NG = SAMPLE ? 1 : 4;
#pragma unroll 1
    for (int g = 0; g < NG; ++g) {
        const int head = kvh * 4 + (SAMPLE ? (r & 3) : g);
        const bool colok = !SAMPLE || r < 4;
        bf16x8 qf[4];
        { const bf16* qp = PROJ + (SAMPLE ? srow : R0 + q0 + r) * NIN + head * 64 + 8 * hh;
#pragma unroll
          for (int ds = 0; ds < 4; ++ds) qf[ds] = colok ? *(const bf16x8*)(qp + 16 * ds) : zero8; }
        const float slope2 = __builtin_amdgcn_exp2f(-(float)(head + 1)) * LOG2E, sink2 = sinks[head] * LOG2E;
        float mx = sink2, lh = 0.f;
        f32x16 O[2];
#pragma unroll
        for (int k = 0; k < 16; ++k) { O[0][k] = 0.f; O[1][k] = 0.f; }
        const int rb = SAMPLE ? -4 * hh : r - 4 * hh;
#pragma unroll 1
        for (int i = nskip; i < 5; ++i) {
            f32x16 S;
#pragma unroll
            for (int k = 0; k < 16; ++k) S[k] = 0.f;
            if (!SAMPLE || i < 4) {
                const bf16* kpb = PROJ + (R0 + q0 - 128 + 32 * i + r) * NIN + 512 + kvh * 64 + 8 * hh;
                const float* kpf = cache_k + ((size_t)(b * 128 + 32 * i + r) * 2 + kvh) * 64 + 8 * hh;
#pragma unroll
                for (int ds = 0; ds < 4; ++ds) {
                    bf16x8 kf;
                    if (!SAMPLE) kf = *(const bf16x8*)(kpb + 16 * ds);
                    else { const f32x4 a = *(const f32x4*)(kpf + 16 * ds), c = *(const f32x4*)(kpf + 16 * ds + 4); kf = pack8(a[0], a[1], a[2], a[3], c[0], c[1], c[2], c[3]); }
                    S = __builtin_amdgcn_mfma_f32_32x32x16_bf16(kf, qf[ds], S, 0, 0, 0);
                }
            } else {
#pragma unroll
                for (int ds = 0; ds < 4; ++ds) {
                    const bf16x8 kn = *(const bf16x8*)(PROJ + srow * NIN + 512 + kvh * 64 + 16 * ds + 8 * hh); const bf16x8 kf = (r == 0) ? kn : zero8;
                    S = __builtin_amdgcn_mfma_f32_32x32x16_bf16(kf, qf[ds], S, 0, 0, 0);
                }
            }
            const int relb = 128 - 32 * i + rb;
            float tm = -1e30f;
#pragma unroll
            for (int k = 0; k < 16; ++k) {
                const int rel = relb - ((k & 3) + 8 * (k >> 2));
                const bool valid = SAMPLE ? (rel >= 0) : ((unsigned)rel <= 128u);
                const float sc = valid ? S[k] * (0.125f * LOG2E) - slope2 * (float)rel : -1e30f;
                S[k] = sc; tm = fmaxf(tm, sc);
            }
            tm = fmaxf(tm, __shfl_xor(tm, 32));
            const float mn = fmaxf(mx, tm), alpha = __builtin_amdgcn_exp2f(mx - mn); mx = mn;
            float ps = 0.f;
#pragma unroll
            for (int k = 0; k < 16; ++k) { const float p = __builtin_amdgcn_exp2f(S[k] - mn); S[k] = p; ps += p; }
            lh = lh * alpha + ps;
#pragma unroll
            for (int k = 0; k < 16; ++k) { O[0][k] *= alpha; O[1][k] *= alpha; }
            const LAS unsigned short* vt = vrd + i * 2048;
#pragma unroll
            for (int s = 0; s < 2; ++s) {
                const bf16x8 pf = pack8(S[8 * s + 0], S[8 * s + 1], S[8 * s + 2], S[8 * s + 3], S[8 * s + 4], S[8 * s + 5], S[8 * s + 6], S[8 * s + 7]);
#pragma unroll
                for (int db = 0; db < 2; ++db) {
                    u16x8 e;
#pragma unroll
                    for (int j = 0; j < 8; ++j) e[j] = vt[(16 * s + 8 * (j >> 2) + (j & 3)) * 64 + 32 * db];
                    O[db] = __builtin_amdgcn_mfma_f32_32x32x16_bf16(__builtin_bit_cast(bf16x8, e), pf, O[db], 0, 0, 0);
                }
            }
        }
        const float l = lh + __shfl_xor(lh, 32) + __builtin_amdgcn_exp2f(sink2 - mx);
        const float il = 1.0f / l;
        if (colok) {
            bf16* op = MIX + (SAMPLE ? srow : R0 + q0 + r) * DM + head * 64 + 4 * hh;
#pragma unroll
            for (int db = 0; db < 2; ++db)
#pragma unroll
                for (int k4 = 0; k4 < 4; ++k4) { pg8::u32x2 w; w.x = cvtpk(O[db][4 * k4] * il, O[db][4 * k4 + 1] * il); w.y = cvtpk(O[db][4 * k4 + 2] * il, O[db][4 * k4 + 3] * il);
                    *(pg8::u32x2*)(op + 32 * db + 8 * k4) = w; }
        }
    }
}

template <int NCH, class Epi>
__device__ __forceinline__ void small_tile(const bf16* X, int ldx, int m0, const bf16* Wt, int K, int nA, int nB, LAS float* red, int wave, int lane, const Epi& E) {
    const int r = lane & 31, hh = lane >> 5, ksl = K >> 3;
    f32x16 acc[NCH];
#pragma unroll
    for (int c = 0; c < NCH; ++c)
#pragma unroll
        for (int k = 0; k < 16; ++k) acc[c][k] = 0.f;
    const bf16* xp = X + (size_t)(m0 + r) * ldx + wave * ksl + 8 * hh;
    const bf16* wa = Wt + (size_t)(nA + r) * K + wave * ksl + 8 * hh;
    const bf16* wb = Wt + (size_t)(nB + r) * K + wave * ksl + 8 * hh;
#pragma unroll 4
    for (int ks = 0; ks < (ksl >> 4); ++ks) {
        const bf16x8 xb = *(const bf16x8*)(xp + 16 * ks);
        acc[0] = __builtin_amdgcn_mfma_f32_32x32x16_bf16(*(const bf16x8*)(wa + 16 * ks), xb, acc[0], 0, 0, 0);
        if (NCH == 2) acc[NCH - 1] = __builtin_amdgcn_mfma_f32_32x32x16_bf16(*(const bf16x8*)(wb + 16 * ks), xb, acc[NCH - 1], 0, 0, 0);
    }
#pragma unroll
    for (int c = 0; c < NCH; ++c)
#pragma unroll
        for (int k = 0; k < 16; ++k) red[((wave * NCH + c) * 16 + k) * 64 + lane] = acc[c][k];
    __syncthreads();
    if (wave == 0) {
#pragma unroll 1
        for (int w = 1; w < 8; ++w) {
#pragma unroll
            for (int c = 0; c < NCH; ++c)
#pragma unroll
                for (int k = 0; k < 16; ++k) acc[c][k] += red[((w * NCH + c) * 16 + k) * 64 + lane];
        }
        E(acc, m0 + r, hh);
    }
    __syncthreads();
}
struct SEpiProj { bf16* P; const float* rstd; float* out; int n0;
    __device__ __forceinline__ void operator()(const f32x16 (&t)[1], int row, int hh) const {
        const float rs = rstd[row];
#pragma unroll
        for (int q = 0; q < 4; ++q) { const int col = n0 + 8 * q + 4 * hh; const f32x4 v = {t[0][4 * q] * rs, t[0][4 * q + 1] * rs, t[0][4 * q + 2] * rs, t[0][4 * q + 3] * rs};
            pg8::u32x2 w; w.x = cvtpk(v[0], v[1]); w.y = cvtpk(v[2], v[3]); *(pg8::u32x2*)(P + (size_t)row * NIN + col) = w;
            if (col >= 512) { float* d = pg8::side_dst(out, row, col); if (d) *(f32x4*)d = v; } }
    } };
template <bool FIRST> struct SEpiRes { const float* xs; float* out; bf16* XN; float* SSs; int n0;
    __device__ __forceinline__ void operator()(const f32x16 (&t)[1], int row, int hh) const {
        const int b = row - MP; float ss = 0.f;
#pragma unroll
        for (int q = 0; q < 4; ++q) { const int col = n0 + 8 * q + 4 * hh; float* op = out + (size_t)row * DM + col;
            const f32x4 base = FIRST ? *(const f32x4*)(xs + (size_t)b * DM + col) : *(const f32x4*)op;
            const f32x4 v = {base[0] + t[0][4 * q], base[1] + t[0][4 * q + 1], base[2] + t[0][4 * q + 2], base[3] + t[0][4 * q + 3]};
            *(f32x4*)op = v;
            if (FIRST) { pg8::u32x2 w; w.x = cvtpk(v[0], v[1]); w.y = cvtpk(v[2], v[3]); *(pg8::u32x2*)(XN + (size_t)row * DM + col) = w; }
            ss += (v[0] * v[0] + v[1] * v[1]) + (v[2] * v[2] + v[3] * v[3]); }
        ss += __shfl_xor(ss, 32);
        if (hh == 0) SSs[b * 32 + (n0 >> 5)] = ss;
    } };
struct SEpiSwiGLU { bf16* H; const float* SSs; int hc0;
    __device__ __forceinline__ void operator()(const f32x16 (&t)[2], int row, int hh) const {
        const int b = row - MP; const f32x4* sp = (const f32x4*)(SSs + b * 32);
        f32x4 a = sp[0];
#pragma unroll
        for (int i = 1; i < 8; ++i) a += sp[i];
        const float rs = 1.0f / sqrtf(((a[0] + a[1]) + (a[2] + a[3])) * (1.0f / DM) + pg8::RMS_EPS);
#pragma unroll
        for (int q = 0; q < 4; ++q) { float hv[4];
#pragma unroll
            for (int e = 0; e < 4; ++e) { const float g = t[0][4 * q + e] * rs, uu = t[1][4 * q + e] * rs; hv[e] = g * __builtin_amdgcn_rcpf(1.0f + __builtin_amdgcn_exp2f(-LOG2E * g)) * uu; }
            pg8::u32x2 w; w.x = cvtpk(hv[0], hv[1]); w.y = cvtpk(hv[2], hv[3]); *(pg8::u32x2*)(H + (size_t)row * DFF + hc0 + 8 * q + 4 * hh) = w; }
    } };

__device__ __forceinline__ void pool_unit(const bf16* PROJ, const float* state_pool, const bf16* Wp_t, const float* pool_scale, bf16* MIX, int rt, int g, int lane) {
    const int r = lane & 31, hh = lane >> 5, w = 2 << g;
    const int row = rt * 32 + r;
    const bool smp = rt >= MP / 32;
    const int t = row & 4095, n = smp ? 0 : ((w - 1) < t ? (w - 1) : t);
    const float icnt = smp ? 1.0f / (float)w : 1.0f / (float)(n + 1);
    bf16x8 mf[8];
#pragma unroll
    for (int ks = 0; ks < 8; ++ks) {
        const int c = g * 128 + 16 * ks + 8 * hh;
        const bf16* up = PROJ + (size_t)row * NIN + 768 + c;
        const v4u sv = *(const v4u*)up;
        float self[8] = {bflo(sv.x), bfhi(sv.x), bflo(sv.y), bfhi(sv.y), bflo(sv.z), bfhi(sv.z), bflo(sv.w), bfhi(sv.w)};
        float sum[8];
#pragma unroll
        for (int e = 0; e < 8; ++e) sum[e] = self[e];
        if (!smp) {
#pragma unroll 2
            for (int k = 1; k < w; ++k)
                if (k <= n) { const v4u pv = *(const v4u*)(up - (size_t)k * NIN);
                    sum[0] += bflo(pv.x); sum[1] += bfhi(pv.x); sum[2] += bflo(pv.y); sum[3] += bfhi(pv.y); sum[4] += bflo(pv.z); sum[5] += bfhi(pv.z); sum[6] += bflo(pv.w); sum[7] += bfhi(pv.w); }
        } else {
            const float* hp = state_pool + (size_t)(row - MP) * 15 * 512 + c;
#pragma unroll 2
            for (int j = 16 - w; j <= 14; ++j) { const f32x4 a = *(const f32x4*)(hp + j * 512), d = *(const f32x4*)(hp + j * 512 + 4);
                sum[0] += a[0]; sum[1] += a[1]; sum[2] += a[2]; sum[3] += a[3]; sum[4] += d[0]; sum[5] += d[1]; sum[6] += d[2]; sum[7] += d[3]; }
        }
        mf[ks] = pack8(sum[0] * icnt - self[0], sum[1] * icnt - self[1], sum[2] * icnt - self[2], sum[3] * icnt - self[3], sum[4] * icnt - self[4], sum[5] * icnt - self[5], sum[6] * icnt - self[6], sum[7] * icnt - self[7]);
    }
    const bf16* wp = Wp_t + (size_t)g * 128 * 128 + (size_t)r * 128 + 8 * hh;
#pragma unroll 1
    for (int db = 0; db < 4; ++db) {
        f32x16 acc;
#pragma unroll
        for (int k = 0; k < 16; ++k) acc[k] = 0.f;
#pragma unroll
        for (int ks = 0; ks < 8; ++ks) acc = __builtin_amdgcn_mfma_f32_32x32x16_bf16(*(const bf16x8*)(wp + (size_t)db * 32 * 128 + 16 * ks), mf[ks], acc, 0, 0, 0);
        bf16* op = MIX + (size_t)row * DM + 512 + g * 128 + db * 32 + 4 * hh;
        const float* sp = pool_scale + g * 128 + db * 32 + 4 * hh;
#pragma unroll
        for (int q = 0; q < 4; ++q) { const f32x4 sc = *(const f32x4*)(sp + 8 * q);
            pg8::u32x2 o; o.x = cvtpk(acc[4 * q] * sc[0], acc[4 * q + 1] * sc[1]); o.y = cvtpk(acc[4 * q + 2] * sc[2], acc[4 * q + 3] * sc[3]); *(pg8::u32x2*)(op + 8 * q) = o; }
    }
}
#ifndef REP0
#define REP0 1
#define REP1 1
#define REP2A 1
#define REP2B 1
#define REP3 1
#define REP4 1
#define REPBAR 1
#endif
struct Args { const float* in[16]; float* out; unsigned char* ws; };

__global__ void __launch_bounds__(NWAVES * 64, 2) hymba_fwd(Args args) {
    extern __shared__ __attribute__((aligned(16))) unsigned char lds[];
    LAS unsigned char* const L = (LAS unsigned char*)lds;
    volatile LAS unsigned* const MISC = (volatile LAS unsigned*)(L + MISC_OFF);
#define FRESH_IDS() int tid = threadIdx.x; asm volatile("" : "+v"(tid)); const int lane = tid & 63, wave = __builtin_amdgcn_readfirstlane(tid >> 6); const int gw = vcu * NWAVES + wave; (void)lane; (void)gw
    const int G = gridDim.x; const int bx = blockIdx.x; const int vcu = (G % 8 == 0) ? (bx % 8) * (G / 8) + bx / 8 : bx;
    const int NGW = G * NWAVES;
    unsigned char* const ws = args.ws;
    const float* const x_p = args.in[0]; const float* const x_s = args.in[1]; const float* const cache_k = args.in[2]; const float* const cache_v = args.in[3];
    const float* const state_pool = args.in[4]; const float* const norm1 = args.in[5]; const float* const w_in = args.in[6]; const float* const sinks = args.in[7];
    const float* const w_pool = args.in[8]; const float* const pool_scale = args.in[9]; const float* const w_out = args.in[10]; const float* const norm2 = args.in[11];
    const float* const w_gate = args.in[12]; const float* const w_up = args.in[13]; const float* const w_down = args.in[14]; const float* const final_norm = args.in[15];
    float* const out = args.out;
    gu32* const ctl = (gu32*)(ws + WS_CTL);
    float* const RSTD = (float*)(ws + WS_RSTD); float* const SS2 = (float*)(ws + WS_SS2); float* const SS3 = (float*)(ws + WS_SS3);
    float* const SSs2 = (float*)(ws + WS_SS2 + 0x110000); float* const SSs3 = (float*)(ws + WS_SS3 + 0x110000);
    bf16* const Win_t = (bf16*)(ws + WS_WIN); bf16* const Wout_t = (bf16*)(ws + WS_WOUT); bf16* const Wgu_t = (bf16*)(ws + WS_WGU); bf16* const Wd_t = (bf16*)(ws + WS_WD); bf16* const Wp_t = (bf16*)(ws + WS_WPOOL);
    bf16* const XN = (bf16*)(ws + WS_XN); bf16* const PROJ = (bf16*)(ws + WS_PROJ); bf16* const MIX = (bf16*)(ws + WS_MIX); bf16* const HB = (bf16*)(ws + WS_H);

    for (int u = threadIdx.x; u < (LDS_BYTES - LDSCTL_OFF) / 4; u += NWAVES * 64) ((LAS unsigned*)(L + LDSCTL_OFF))[u] = 0u;
    __syncthreads();
    XcdBarrier bar = xcd_barrier_post((unsigned*)(ctl + CW_BAR), MISC + 8);

    for (int rep = 0; rep < REP0; ++rep)
    {
        FRESH_IDS();
        LAS float* scr = (LAS float*)(L + RING_OFF + wave * 16384);
        constexpr int I_IN = (DM / 64) * (NIN / 32), I_OUT = (DM / 64) * (DM / 32), I_G = (DM / 64) * (DFF / 32), I_D = (DFF / 64) * (DM / 32);
        constexpr int NITEMS = I_IN + I_OUT + 2 * I_G + I_D + 32;
        for (int it = gw; it < NITEMS; it += NGW) {
            int r = it;
            if (r < I_IN) { p0_transpose_item<0>(w_in, DM, NIN, norm1, Win_t, scr, r, lane); continue; } r -= I_IN;
            if (r < I_OUT) { p0_transpose_item<0>(w_out, DM, DM, nullptr, Wout_t, scr, r, lane); continue; } r -= I_OUT;
            if (r < I_G) { p0_transpose_item<1>(w_gate, DM, DFF, norm2, Wgu_t, scr, r, lane); continue; } r -= I_G;
            if (r < I_G) { p0_transpose_item<2>(w_up, DM, DFF, norm2, Wgu_t, scr, r, lane); continue; } r -= I_G;
            if (r < I_D) { p0_transpose_item<0>(w_down, DFF, DM, nullptr, Wd_t, scr, r, lane); continue; } r -= I_D;
            p0_transpose_item<0>(w_pool + (size_t)(r >> 3) * 16384, 128, 128, nullptr, Wp_t + (size_t)(r >> 3) * 16384, scr, r & 7, lane);
        }
        for (int m = gw; m < MPAD; m += NGW) {
            GAS unsigned long long* o8 = (GAS unsigned long long*)(XN + (size_t)m * DM) + lane;
            if (m < MV) {
                const float* xrow = (m < MP) ? x_p + (size_t)m * DM : x_s + (size_t)(m - MP) * DM;
                const GAS f32x4* xr = (const GAS f32x4*)xrow + lane;
                f32x4 v[4]; float s = 0.f;
#pragma unroll
                for (int j = 0; j < 4; ++j) { v[j] = xr[64 * j]; s += (v[j].x * v[j].x + v[j].y * v[j].y) + (v[j].z * v[j].z + v[j].w * v[j].w); }
                const float rstd = 1.f / sqrtf(wave_sum(s) * (1.f / DM) + pg8::RMS_EPS);
                if (lane == 0) RSTD[m] = rstd;
#pragma unroll
                for (int j = 0; j < 4; ++j) o8[64 * j] = (unsigned long long)pk2(v[j].x, v[j].y) | ((unsigned long long)pk2(v[j].z, v[j].w) << 32);
            } else {
                if (lane == 0) RSTD[m] = 0.f;
#pragma unroll
                for (int j = 0; j < 4; ++j) o8[64 * j] = 0ull;
            }
        }
        {
            const int gt = gw * 64 + lane, NT = NGW * 64;
            const f32x4* ck4 = (const f32x4*)cache_k; const f32x4* cv4 = (const f32x4*)cache_v; const f32x4* sp4 = (const f32x4*)state_pool;
            f32x4* ok4 = (f32x4*)(out + pg8::OFF_KS); f32x4* ov4 = (f32x4*)(out + pg8::OFF_VS); f32x4* op4 = (f32x4*)(out + pg8::OFF_PS);
            for (int i = gt; i < 128 * 127 * 32; i += NT) { const int b = i / (127 * 32), r = i % (127 * 32); ok4[b * 4096 + r] = ck4[b * 4096 + 32 + r]; ov4[b * 4096 + r] = cv4[b * 4096 + 32 + r]; }
            for (int i = gt; i < 128 * 14 * 128; i += NT) { const int b = i / (14 * 128), r = i % (14 * 128); op4[b * 1920 + r] = sp4[b * 1920 + 128 + r]; }
        }
    }
    xcd_barrier(bar);

    for (int rep = 0; rep < REP1; ++rep)
    {
        FRESH_IDS();
        pg8::Gemm g{XN, Win_t, MP, NIN, DM}; pg8::StaticOrder S; S.init(MP, NIN, G, bx);
        pg8::EpiProj E{PROJ, RSTD, out};
        pg8::gemm_phase<pg8::EpiProj, pg8::StaticOrder, true, true>(L + RING_OFF, g, S, E);
        for (int ti = (bx + G - 64 % G) % G; ti < 160; ti += G) {
            SEpiProj SE{PROJ, RSTD, out, (ti >> 2) * 32};
            small_tile<1>(XN, DM, MP + (ti & 3) * 32, Win_t, DM, (ti >> 2) * 32, 0, (LAS float*)(L + RING_OFF), wave, lane, SE);
        }
    }
    xcd_barrier(bar);

    {
        FRESH_IDS();
        for (int rep = 0; rep < REP2A; ++rep)
        for (int u = wave * G + vcu; u < 1280; u += NGW) {
            if (u < 1024) attn_unit<false>(PROJ, cache_k, cache_v, sinks, MIX, L + RING_OFF + wave * 20480, u >> 8, (u >> 7) & 1, u & 127, lane);
            else attn_unit<true>(PROJ, cache_k, cache_v, sinks, MIX, L + RING_OFF + wave * 20480, (u - 1024) & 127, (u - 1024) >> 7, 0, lane);
        }
        for (int rep = 0; rep < REP2B; ++rep)
        for (int pu = (wave - 5) * G + vcu; pu >= 0 && pu < (MV / 32) * 4; pu += 3 * G) pool_unit(PROJ, state_pool, Wp_t, pool_scale, MIX, pu >> 2, pu & 3, lane);
    }
    xcd_barrier(bar);

    for (int rep = 0; rep < REP3; ++rep)
    {
        FRESH_IDS();
        pg8::Gemm g{MIX, Wout_t, MP, DM, DM}; pg8::StaticOrder S; S.init(MP, DM, G, bx);
        pg8::EpiRes<true> E{x_p, x_s, out, XN, SS2};
        pg8::gemm_phase<pg8::EpiRes<true>, pg8::StaticOrder, true, true>(L + RING_OFF, g, S, E);
        for (int ti = bx; ti < 128; ti += G) {
            SEpiRes<true> SE{x_s, out, XN, SSs2, (ti >> 2) * 32};
            small_tile<1>(MIX, DM, MP + (ti & 3) * 32, Wout_t, DM, (ti >> 2) * 32, 0, (LAS float*)(L + RING_OFF), wave, lane, SE);
        }
    }
    xcd_barrier(bar);

    for (int rep = 0; rep < REP4; ++rep)
    {
        FRESH_IDS();
        pg8::Gemm g{XN, Wgu_t, MP, 2 * DFF, DM}; pg8::StaticOrder S; S.init(MP, 2 * DFF, G, bx);
        pg8::EpiSwiGLU E{HB, SS2};
        pg8::gemm_phase<pg8::EpiSwiGLU, pg8::StaticOrder, true, true>(L + RING_OFF, g, S, E);
        for (int ti = (bx + G - 128 % G) % G; ti < 352; ti += (G >= 256 ? 128 : G)) {
            const int hc0 = (ti >> 2) * 32, nA = (hc0 >> 7) * 256 + (hc0 & 127);
            SEpiSwiGLU SE{HB, SSs2, hc0};
            small_tile<2>(XN, DM, MP + (ti & 3) * 32, Wgu_t, DM, nA, nA + 128, (LAS float*)(L + RING_OFF), wave, lane, SE);
        }
    }
    xcd_barrier(bar);

    {
        FRESH_IDS();
        pg8::Gemm g{HB, Wd_t, MP, DM, DFF}; pg8::StaticOrder S; S.init(MP, DM, G, bx);
        pg8::EpiRes<false> E{nullptr, nullptr, out, nullptr, SS3};
        pg8::gemm_phase<pg8::EpiRes<false>, pg8::StaticOrder, true, true>(L + RING_OFF, g, S, E);
        for (int ti = bx; ti < 128; ti += G) {
            SEpiRes<false> SE{nullptr, out, nullptr, SSs3, (ti >> 2) * 32};
            small_tile<1>(HB, DFF, MP + (ti & 3) * 32, Wd_t, DFF, (ti >> 2) * 32, 0, (LAS float*)(L + RING_OFF), wave, lane, SE);
        }
    }
    for (int rep = 0; rep < REPBAR; ++rep) xcd_barrier(bar);

    {
        FRESH_IDS();
        const unsigned poison = xb_ld((unsigned*)(ctl + CW_BAR) + XB_TMO);
        for (int m = gw; m < MV; m += NGW) {
            f32x4 a;
            if (m < MP) { const f32x4* sp = (const f32x4*)(SS3 + (size_t)m * 16); a = (sp[0] + sp[1]) + (sp[2] + sp[3]); }
            else { const f32x4* sp = (const f32x4*)(SSs3 + (m - MP) * 32); a = ((sp[0] + sp[1]) + (sp[2] + sp[3])) + ((sp[4] + sp[5]) + (sp[6] + sp[7])); }
            float rs = 1.0f / sqrtf(((a[0] + a[1]) + (a[2] + a[3])) * (1.0f / DM) + pg8::RMS_EPS);
            if (poison) rs = __builtin_nanf("");
            GAS f32x4* xr = (GAS f32x4*)(out + (size_t)m * DM) + lane; const f32x4* gf = (const f32x4*)final_norm + lane;
#pragma unroll
            for (int j = 0; j < 4; ++j) { const f32x4 v = xr[64 * j]; xr[64 * j] = v * rs * gf[64 * j]; }
        }
    }
}

extern "C" void kernel_launch(void* const* d_in, const int* in_sizes, int n_in, void* d_out, int out_size, void* d_ws, size_t ws_size, hipStream_t stream) {
    static int grid = 0;
    if (grid == 0) {
        if (n_in != 16 || out_size != (int)pg8::OUT_TOTAL || ws_size < WS_END) { fprintf(stderr, "kernel_launch: unexpected shapes (n_in %d, out %d, ws %zu); nothing launched\n", n_in, out_size, ws_size); grid = -1; return; }
        int dev = 0, cus = 0, per_cu = 0;
        if (hipGetDevice(&dev) != hipSuccess || hipDeviceGetAttribute(&cus, hipDeviceAttributeMultiprocessorCount, dev) != hipSuccess) { grid = -1; return; }
        if (hipFuncSetAttribute((const void*)hymba_fwd, hipFuncAttributeMaxDynamicSharedMemorySize, LDS_BYTES) != hipSuccess) { fprintf(stderr, "kernel_launch: hipFuncSetAttribute failed\n"); grid = -1; return; }
        if (hipOccupancyMaxActiveBlocksPerMultiprocessor(&per_cu, (const void*)hymba_fwd, NWAVES * 64, LDS_BYTES) != hipSuccess || per_cu < 1)
            fprintf(stderr, "kernel_launch: note: occupancy query reports %d workgroups per CU\n", per_cu);
        (void)hipGetLastError();
        grid = cus;
    }
    if (grid < 0) return;
    if (hipMemsetAsync((char*)d_ws + WS_CTL, 0, CTL_ZERO_BYTES, stream) != hipSuccess) { fprintf(stderr, "kernel_launch: hipMemsetAsync failed\n"); return; }
    Args a{};
    for (int i = 0; i < 16; ++i) a.in[i] = (const float*)d_in[i];
    a.out = (float*)d_out; a.ws = (unsigned char*)d_ws;
    hipLaunchKernelGGL(hymba_fwd, dim3(grid), dim3(NWAVES * 64), LDS_BYTES, stream, a);
}
```
